# Optimizing an MI355X kernel written in HIP

```python
import jax, jax.numpy as jnp
from jax import lax
import numpy as np

D_MODEL = 1024
BATCH = 8
SEQ = 4096
DEPTH = 4

GRID_W = 64
CTX_LEN = 256
D_FF = 2816
N_MOD = 9
W_FOURIER = 256
FOURIER_GROUPS = 4
W_LRU = 512
LRU_HEADS = 8
W_SC = 256
LRU_CONV = 4
SC_CONV = 3
LRU_C = 8.0
N_BRANCH = 3
RMS_EPS = 1e-6
OFF_F = 0
OFF_LX = OFF_F + W_FOURIER
OFF_LG = OFF_LX + W_LRU
OFF_SB = OFF_LG + W_LRU
OFF_SC = OFF_SB + W_SC
OFF_SX = OFF_SC + W_SC
OFF_G = OFF_SX + W_SC
IN_COLS = OFF_G + N_BRANCH * D_MODEL

kernel_name = "hybrid_fourier_rglru_shortconv_macaron_dit"


def rms_norm(x, g):
    xf = x.astype(jnp.float32)
    y = xf * lax.rsqrt(jnp.mean(xf * xf, axis=-1, keepdims=True) + RMS_EPS)
    return (y * g.astype(jnp.float32)).astype(x.dtype)


def modulate(x, shift, scale):
    return x * (1 + scale) + shift


def swiglu(x, wg, wu, wd):
    return (jax.nn.silu(x @ wg) * (x @ wu)) @ wd


def dw_conv(x, w, pad_left):
    k = w.shape[0]
    length = x.shape[1]
    xp = jnp.pad(x, ((0, 0), (pad_left, k - 1 - pad_left), (0, 0)))
    return sum(xp[:, j:j + length] * w[j] for j in range(k))


def lru_conv(x, w, b):
    return dw_conv(x, w, LRU_CONV // 2) + b


def short_conv_seq(x, w):
    return dw_conv(x, w, SC_CONV // 2)


def short_conv_latent(x, w):
    b, length, ch = x.shape
    rows = length // GRID_W
    y = dw_conv(x.reshape(b * rows, GRID_W, ch), w, SC_CONV // 2)
    return y.reshape(b, length, ch)


def fourier_mix(xf):
    b, length, _ = xf.shape
    z = xf.astype(jnp.float32).reshape(b, length, FOURIER_GROUPS, W_FOURIER // FOURIER_GROUPS)
    z = jnp.fft.fft2(z, axes=(1, 3), norm="ortho").real
    return z.reshape(b, length, W_FOURIER).astype(xf.dtype)


def _combine(left, right):
    return (left[0] * right[0], right[0] * left[1] + right[1])


def rglru_scan(xc, wa, ba, wx, bx, lam, h0):
    b, length, w = xc.shape
    xc = xc.astype(jnp.float32)
    xh = xc.reshape(b, length, LRU_HEADS, w // LRU_HEADS)
    r = jax.nn.sigmoid(jnp.einsum("blhi,hij->blhj", xh, wa.astype(jnp.float32))
                       + ba.astype(jnp.float32)).reshape(b, length, w)
    i = jax.nn.sigmoid(jnp.einsum("blhi,hij->blhj", xh, wx.astype(jnp.float32))
                       + bx.astype(jnp.float32)).reshape(b, length, w)
    log_a = -LRU_C * r * jax.nn.softplus(-lam.astype(jnp.float32))
    a = jnp.exp(log_a)
    bterm = jnp.sqrt(-jnp.expm1(2.0 * log_a)) * (i * xc)
    a_cum, h = lax.associative_scan(_combine, (a, bterm), axis=1)
    if h0 is not None:
        h = h + a_cum * h0[:, None, :]
    return h, h[:, -1]


def rglru_bidir(xc, wa, ba, wx, bx, lam, h0_f, h0_b):
    hf, last_f = rglru_scan(xc, wa[0], ba[0], wx[0], bx[0], lam[0], h0_f)
    hb_rev, last_b = rglru_scan(jnp.flip(xc, 1), wa[1], ba[1], wx[1], bx[1], lam[1], h0_b)
    return hf, jnp.flip(hb_rev, 1), last_f, last_b


def merge_branches(p, y_lru, sc_conv_fn, sc_w, wp_f, wp_l, wp_c, w_out):
    y_f = fourier_mix(p[..., OFF_F:OFF_LX])
    y_l = y_lru.astype(p.dtype) * jax.nn.gelu(p[..., OFF_LG:OFF_SB])
    y_c = p[..., OFF_SB:OFF_SC] * sc_conv_fn(p[..., OFF_SC:OFF_SX] * p[..., OFF_SX:OFF_G], sc_w)
    g_f, g_l, g_c = jnp.split(jax.nn.sigmoid(p[..., OFF_G:]), N_BRANCH, axis=-1)
    m = g_f * (y_f @ wp_f) + g_l * (y_l @ wp_l) + g_c * (y_c @ wp_c)
    return m @ w_out


def setup_inputs(seed: int = 0) -> dict:
    key = jax.random.key(seed)
    ks = jax.random.split(key, 26)

    def nrm(k, shape, scale):
        return jax.random.normal(k, shape, jnp.float32) * scale

    u = jax.random.uniform(ks[19], (DEPTH, 2, W_LRU), jnp.float32, 0.9, 0.999)
    s = u ** (1.0 / LRU_C)
    lru_lambda = jnp.log(s) - jnp.log1p(-s)
    blk = W_LRU // LRU_HEADS
    return {
        "x": nrm(ks[0], (BATCH, SEQ, D_MODEL), 1.0),
        "c": nrm(ks[1], (BATCH, D_MODEL), 1.0),
        "ctx": nrm(ks[2], (BATCH, CTX_LEN, D_MODEL), 1.0),
        "c_ctx": nrm(ks[3], (D_MODEL,), 1.0),
        "w_ada": nrm(ks[4], (DEPTH, D_MODEL, N_MOD * D_MODEL), 0.5 * D_MODEL ** -0.5),
        "b_ada": nrm(ks[5], (DEPTH, N_MOD * D_MODEL), 0.01),
        "g_ffn1": 1.0 + nrm(ks[6], (DEPTH, D_MODEL), 0.01),
        "g_mix": 1.0 + nrm(ks[7], (DEPTH, D_MODEL), 0.01),
        "g_ffn2": 1.0 + nrm(ks[8], (DEPTH, D_MODEL), 0.01),
        "ffn_w_gate": nrm(ks[9], (DEPTH, 2, D_MODEL, D_FF), D_MODEL ** -0.5),
        "ffn_w_up": nrm(ks[10], (DEPTH, 2, D_MODEL, D_FF), D_MODEL ** -0.5),
        "ffn_w_down": nrm(ks[11], (DEPTH, 2, D_FF, D_MODEL), D_FF ** -0.5),
        "w_in": nrm(ks[12], (DEPTH, D_MODEL, IN_COLS), D_MODEL ** -0.5),
        "lru_conv_w": nrm(ks[13], (DEPTH, LRU_CONV, W_LRU), LRU_CONV ** -0.5),
        "lru_conv_b": nrm(ks[14], (DEPTH, W_LRU), 0.01),
        "lru_wa": nrm(ks[15], (DEPTH, 2, LRU_HEADS, blk, blk), blk ** -0.5),
        "lru_ba": nrm(ks[16], (DEPTH, 2, LRU_HEADS, blk), 0.01),
        "lru_wx": nrm(ks[17], (DEPTH, 2, LRU_HEADS, blk, blk), blk ** -0.5),
        "lru_bx": nrm(ks[18], (DEPTH, 2, LRU_HEADS, blk), 0.01),
        "lru_lambda": lru_lambda,
        "sc_conv_w": nrm(ks[20], (DEPTH, SC_CONV, W_SC), SC_CONV ** -0.5),
        "wp_fourier": nrm(ks[21], (DEPTH, W_FOURIER, D_MODEL), W_FOURIER ** -0.5),
        "wp_lru": nrm(ks[22], (DEPTH, W_LRU, D_MODEL), W_LRU ** -0.5),
        "wp_conv": nrm(ks[23], (DEPTH, W_SC, D_MODEL), W_SC ** -0.5),
        "w_out": nrm(ks[24], (DEPTH, D_MODEL, D_MODEL), D_MODEL ** -0.5),
        "g_final": 1.0 + nrm(ks[25], (D_MODEL,), 0.01),
    }


def reference(x, c, ctx, c_ctx, w_ada, b_ada, g_ffn1, g_mix, g_ffn2, ffn_w_gate, ffn_w_up,
              ffn_w_down, w_in, lru_conv_w, lru_conv_b, lru_wa, lru_ba, lru_wx, lru_bx,
              lru_lambda, sc_conv_w, wp_fourier, wp_lru, wp_conv, w_out, g_final):
    h = x
    hc = ctx
    s_lat = jax.nn.silu(c)
    s_ctx = jax.nn.silu(c_ctx)
    for l in range(DEPTH):
        last = l == DEPTH - 1
        m = jnp.split((s_lat @ w_ada[l] + b_ada[l])[:, None, :], N_MOD, axis=-1)
        mc = jnp.split(s_ctx @ w_ada[l] + b_ada[l], N_MOD, axis=-1)

        h = h + 0.5 * m[2] * swiglu(modulate(rms_norm(h, g_ffn1[l]), m[0], m[1]),
                                    ffn_w_gate[l, 0], ffn_w_up[l, 0], ffn_w_down[l, 0])
        hc = hc + 0.5 * mc[2] * swiglu(modulate(rms_norm(hc, g_ffn1[l]), mc[0], mc[1]),
                                       ffn_w_gate[l, 0], ffn_w_up[l, 0], ffn_w_down[l, 0])

        u = modulate(rms_norm(h, g_mix[l]), m[3], m[4])
        uc = modulate(rms_norm(hc, g_mix[l]), mc[3], mc[4])

        if last:
            pc_lru = uc @ w_in[l][:, OFF_LX:OFF_LG]
        else:
            pc = uc @ w_in[l]
            pc_lru = pc[..., OFF_LX:OFF_LG]
        xcc = lru_conv(pc_lru, lru_conv_w[l], lru_conv_b[l])
        cf, cb, cf_last, cb_last = rglru_bidir(xcc, lru_wa[l], lru_ba[l], lru_wx[l], lru_bx[l],
                                               lru_lambda[l], None, None)

        p = u @ w_in[l]
        xcl = lru_conv(p[..., OFF_LX:OFF_LG], lru_conv_w[l], lru_conv_b[l])
        lf, lb, _, _ = rglru_bidir(xcl, lru_wa[l], lru_ba[l], lru_wx[l], lru_bx[l],
                                   lru_lambda[l], cf_last, cb_last)
        h = h + m[5] * merge_branches(p, lf + lb, short_conv_latent, sc_conv_w[l],
                                      wp_fourier[l], wp_lru[l], wp_conv[l], w_out[l])
        if not last:
            hc = hc + mc[5] * merge_branches(pc, cf + cb, short_conv_seq, sc_conv_w[l],
                                             wp_fourier[l], wp_lru[l], wp_conv[l], w_out[l])

        h = h + 0.5 * m[8] * swiglu(modulate(rms_norm(h, g_ffn2[l]), m[6], m[7]),
                                    ffn_w_gate[l, 1], ffn_w_up[l, 1], ffn_w_down[l, 1])
        if not last:
            hc = hc + 0.5 * mc[8] * swiglu(modulate(rms_norm(hc, g_ffn2[l]), mc[6], mc[7]),
                                           ffn_w_gate[l, 1], ffn_w_up[l, 1], ffn_w_down[l, 1])
    return rms_norm(h, g_final)
```

```cpp
#include <hip/hip_runtime.h>
#include <hip/hip_cooperative_groups.h>
#include <cstdio>
namespace cg = cooperative_groups;

#define LAS __attribute__((address_space(3)))
typedef unsigned short bf16_t;
typedef short bf16x8 __attribute__((ext_vector_type(8)));
typedef float f32x4 __attribute__((ext_vector_type(4)));
typedef unsigned u32x4 __attribute__((ext_vector_type(4)));
typedef unsigned u32x2 __attribute__((ext_vector_type(2)));

constexpr int D = 1024, NB = 8, SEQ = 4096, DEPTH = 4, CTX = 256, DFF = 2816;
constexpr int MLAT = NB * SEQ, MCTX = NB * CTX, MTOT = MLAT + MCTX;
constexpr int NGU = 2 * DFF;
constexpr int NIN = 5376;
constexpr int INC = 5120;
constexpr int YLD = 1280;
constexpr int FTLD = SEQ + CTX;
constexpr int DMLD = 8192;
constexpr int NCHUNK = 544;

constexpr size_t WS_MODS = 0;
constexpr size_t WS_AGG  = WS_MODS + (size_t)4 * 9 * 9216 * 4;
constexpr size_t WS_HCTX = WS_AGG + (size_t)NCHUNK * 2 * 2 * 512 * 4;
constexpr size_t WS_ABUF = WS_HCTX + (size_t)MCTX * D * 4;
constexpr size_t WS_WGU  = WS_ABUF + (size_t)MTOT * D * 2;
constexpr size_t WS_WD   = WS_WGU + (size_t)2 * NGU * D * 2;
constexpr size_t WS_WIN  = WS_WD + (size_t)2 * D * DFF * 2;
constexpr size_t WS_WP   = WS_WIN + (size_t)NIN * D * 2;
constexpr size_t WS_WOUT = WS_WP + (size_t)D * YLD * 2;
constexpr size_t WS_DMAT = WS_WOUT + (size_t)D * D * 2;
constexpr size_t WS_MIX  = WS_DMAT + (size_t)FTLD * DMLD * 2;
constexpr size_t WS_FT   = WS_MIX;
constexpr size_t WS_XL   = WS_FT + (size_t)NB * 512 * FTLD * 2;
constexpr size_t WS_GG   = WS_XL + (size_t)MTOT * 512 * 2;
constexpr size_t WS_SCB  = WS_GG + (size_t)MTOT * 512 * 2;
constexpr size_t WS_CX   = WS_SCB + (size_t)MTOT * 256 * 2;
constexpr size_t WS_GATE = WS_CX + (size_t)MTOT * 256 * 2;
constexpr size_t WS_Y    = WS_GATE + (size_t)MTOT * 3072 * 2;
constexpr size_t WS_END  = WS_Y + (size_t)MTOT * YLD * 2;
constexpr size_t WS_FLAGS = WS_END;
constexpr size_t WS_ACT  = WS_MIX;
static_assert((size_t)MTOT * DFF * 2 <= WS_END - WS_MIX, "act alias");

struct Params { const float* in[26]; float* out; unsigned char* ws; };
constexpr int PT_OFF = 131072;
struct PT { LAS const unsigned* tab;
    __device__ __forceinline__ unsigned long long raw(int k) const { const unsigned lo = __builtin_amdgcn_readfirstlane(tab[2 * k]), hi = __builtin_amdgcn_readfirstlane(tab[2 * k + 1]); return ((unsigned long long)hi << 32) | lo; }
    __device__ __forceinline__ const float* in(int k) const { return (const float*)raw(k); }
    __device__ __forceinline__ float* out() const { return (float*)raw(26); }
    __device__ __forceinline__ unsigned char* ws() const { return (unsigned char*)raw(27); } };

typedef __bf16 bf16x2_t __attribute__((ext_vector_type(2)));
typedef float f32x2_t __attribute__((ext_vector_type(2)));
__device__ __forceinline__ unsigned cvt_pk_bf16(float lo, float hi) { const f32x2_t v = {lo, hi}; const bf16x2_t r = __builtin_convertvector(v, bf16x2_t); return __builtin_bit_cast(unsigned, r); }
__device__ __forceinline__ float bf2f(unsigned short b) { return __uint_as_float(((unsigned)b) << 16); }
__device__ __forceinline__ float bflo(unsigned w) { return __uint_as_float(w << 16); }
__device__ __forceinline__ float bfhi(unsigned w) { return __uint_as_float(w & 0xffff0000u); }
__device__ __forceinline__ float sigmoidf_(float x) { return __builtin_amdgcn_rcpf(1.0f + __expf(-x)); }
__device__ __forceinline__ float siluf_(float x) { return x * sigmoidf_(x); }
__device__ __forceinline__ float gelu_tanh_(float x) { const float z = 1.5957691216057308f * (x + 0.044715f * x * x * x); return x * sigmoidf_(z); }

__device__ __forceinline__ int otid() { int t = threadIdx.x; asm volatile("" : "+v"(t)); return t; }

namespace pg8 {
constexpr int BM = 256, BK = 64, HALF = 128, HTB = HALF * BK * 2, STAGE_BYTES = 8 * HTB, NXCD = 8, WGM = 8;
__device__ __forceinline__ int lds_byte(int r, int c) { const int st = (r >> 4) * 2 + (c >> 5), rr = r & 15, cc = c & 31, ob = rr * 64 + cc * 2; return st * 1024 + (ob ^ (((ob >> 9) & 1) << 5)); }
__device__ __forceinline__ void stage_rc(int b, int& R, int& C) { const int st = b / 1024, sb = b % 1024, swz = sb ^ (((sb >> 9) & 1) << 5); R = (st >> 1) * 16 + swz / 64; C = (st & 1) * 32 + (swz % 64) / 2; }
__device__ __forceinline__ int perm32(int rho) { const int n = rho >> 4, i = rho & 15; return 8 * (i >> 2) + 4 * n + (i & 3); }

struct Unit { const char* a; const char* b; int nt, pm, pn, aux; };

struct TileMap {
    int nM, nN, nwg, G, c;
    __device__ void init(int nM_, int nN_, int G_, int c_) { nM = nM_; nN = nN_; nwg = nM * nN; G = G_; c = c_; }
    __device__ bool tile(long L, int& pm, int& pn) const {
        if (L >= nwg) return false;
        int wgid = (int)L; { const int q = nwg / NXCD, r = nwg % NXCD, xcd = wgid % NXCD, off = wgid / NXCD; wgid = (xcd < r ? xcd * (q + 1) : r * (q + 1) + (xcd - r) * q) + off; }
        const int nig = WGM * nN, gid = wgid / nig, fm = gid * WGM, gsz = (nM - fm) < WGM ? (nM - fm) : WGM;
        pm = fm + ((wgid % nig) % gsz); pn = (wgid % nig) / gsz; return true;
    }
};

template <class Epi, class Sched>
__device__ __forceinline__ void gemm_phase(LAS unsigned char* lds, const int lda, const int ldb, const Sched& S, const Epi& E) {
    const int tid = otid(), wid = __builtin_amdgcn_readfirstlane(tid >> 6), lane = tid & 63, wr = wid >> 2, wc = wid & 3, fr = lane & 15, fq = lane >> 4;
    unsigned voffA[2], voffB[2];
#pragma unroll
    for (int i = 0; i < 2; ++i) { int R, C; stage_rc(tid * 16 + i * 8192, R, C); const int Rb = (R & ~31) + perm32(R & 31);
        voffA[i] = (unsigned)(R * lda + C) * 2u; voffB[i] = (unsigned)(Rb * ldb + C) * 2u; }
    const size_t kstep = (size_t)(BK * 2);
    const size_t hstepA = (size_t)HALF * lda * 2, hstepB = (size_t)HALF * ldb * 2;
    const unsigned ldsw = (unsigned)wid * 1024u;
    const int aoff = lds_byte(wr * 64 + fr, fq * 8), boff = lds_byte(wc * 32 + fr, fq * 8);
#define PG8_SA(b, h) (((b) * 2 + (h)) * HTB)
#define PG8_SB(b, h) ((4 + (b) * 2 + (h)) * HTB)
#define PG8_STAGE(bufoff, gbase, voff) do { _Pragma("unroll") for (int _i = 0; _i < 2; ++_i) \
        __builtin_amdgcn_global_load_lds((const unsigned*)((const char*)(gbase) + (voff)[_i]), (LAS unsigned*)(lds + (bufoff) + ldsw + _i * 8192), 16, 0, 0); } while (0)
#define PG8_LDA(dst, b, h) do { _Pragma("unroll") for (int m = 0; m < 4; ++m) _Pragma("unroll") for (int k = 0; k < 2; ++k) dst[m][k] = *(const LAS bf16x8*)(lds + PG8_SA(b, h) + aoff + m * 2048 + k * 1024); } while (0)
#define PG8_LDB(dst, b, h) do { _Pragma("unroll") for (int n = 0; n < 2; ++n) _Pragma("unroll") for (int k = 0; k < 2; ++k) dst[n][k] = *(const LAS bf16x8*)(lds + PG8_SB(b, h) + boff + n * 2048 + k * 1024); } while (0)
#define PG8_MMA(ai, bj, At, Bt) do { __builtin_amdgcn_s_setprio(1); _Pragma("unroll") for (int m = 0; m < 4; ++m) _Pragma("unroll") for (int n = 0; n < 2; ++n) _Pragma("unroll") for (int k = 0; k < 2; ++k) \
        acc[ai][bj][m][n] = __builtin_amdgcn_mfma_f32_16x16x32_bf16(Bt[n][k], At[m][k], acc[ai][bj][m][n], 0, 0, 0); __builtin_amdgcn_s_setprio(0); } while (0)
#define PG8_WAIT_V(n) asm volatile("s_waitcnt vmcnt(" #n ")" ::: "memory")
#define PG8_WAIT_L(n) asm volatile("s_waitcnt lgkmcnt(" #n ")" ::: "memory")
#define PG8_BAR __builtin_amdgcn_s_barrier()
#define PG8_SCHED __builtin_amdgcn_sched_barrier(0)
    Unit cur, nxt; int ui = 0;
    if (!S.next(0, cur)) return;
    f32x4 acc[2][2][4][2];
#pragma unroll
    for (int a = 0; a < 2; ++a)
#pragma unroll
        for (int b = 0; b < 2; ++b)
#pragma unroll
            for (int m = 0; m < 4; ++m)
#pragma unroll
                for (int n = 0; n < 2; ++n) acc[a][b][m][n] = (f32x4){0.f, 0.f, 0.f, 0.f};
    bf16x8 At[4][2], B0[2][2], B1[2][2];
    const char* cA = cur.a; const char* cB = cur.b;
    PG8_STAGE(PG8_SB(0, 0), cB, voffB); PG8_STAGE(PG8_SA(0, 0), cA, voffA); PG8_STAGE(PG8_SB(0, 1), cB + hstepB, voffB); PG8_STAGE(PG8_SA(0, 1), cA + hstepA, voffA);
    if (wr == 1) PG8_BAR;
    PG8_WAIT_V(4); PG8_BAR;
    PG8_STAGE(PG8_SB(1, 0), cB + kstep, voffB); PG8_STAGE(PG8_SA(1, 0), cA + kstep, voffA); PG8_STAGE(PG8_SB(1, 1), cB + hstepB + kstep, voffB);
    PG8_WAIT_V(6); PG8_BAR;
    for (;;) {
        const bool has_next = S.next(ui + 1, nxt);
        const char* nA = has_next ? nxt.a : cA; const char* nB = has_next ? nxt.b : cB;
        const int nt = cur.nt;
        for (int t = 0; t < nt; t += 2) {
            const bool last = (t == nt - 2);
            const char* a1 = cA + (size_t)(t + 1) * kstep;
            const char* a2 = last ? nA : cA + (size_t)(t + 2) * kstep; const char* b2 = last ? nB : cB + (size_t)(t + 2) * kstep;
            const char* a3 = a2 + kstep; const char* b3 = b2 + kstep;
            PG8_LDB(B0, 0, 0); PG8_SCHED; PG8_LDA(At, 0, 0); PG8_STAGE(PG8_SA(1, 1), a1 + hstepA, voffA);
            PG8_WAIT_L(8); PG8_BAR; PG8_WAIT_L(0); PG8_MMA(0, 0, At, B0); PG8_BAR; PG8_SCHED;
            PG8_LDB(B1, 0, 1); PG8_STAGE(PG8_SB(0, 0), b2, voffB);
            PG8_BAR; PG8_WAIT_L(0); PG8_MMA(0, 1, At, B1); PG8_BAR;
            PG8_LDA(At, 0, 1); PG8_STAGE(PG8_SA(0, 0), a2, voffA);
            PG8_BAR; PG8_WAIT_L(0); PG8_MMA(1, 0, At, B0); PG8_BAR; PG8_SCHED;
            PG8_STAGE(PG8_SB(0, 1), b2 + hstepB, voffB);
            PG8_WAIT_V(6); PG8_BAR; PG8_MMA(1, 1, At, B1); PG8_BAR;
            PG8_LDB(B0, 1, 0); PG8_SCHED; PG8_LDA(At, 1, 0); PG8_STAGE(PG8_SA(0, 1), a2 + hstepA, voffA);
            PG8_WAIT_L(8); PG8_BAR; PG8_WAIT_L(0); PG8_MMA(0, 0, At, B0); PG8_BAR; PG8_SCHED;
            PG8_LDB(B1, 1, 1); PG8_STAGE(PG8_SB(1, 0), b3, voffB);
            PG8_BAR; PG8_WAIT_L(0); PG8_MMA(0, 1, At, B1); PG8_BAR;
            PG8_LDA(At, 1, 1); PG8_STAGE(PG8_SA(1, 0), a3, voffA);
            PG8_BAR; PG8_WAIT_L(0); PG8_MMA(1, 0, At, B0); PG8_BAR; PG8_SCHED;
            PG8_STAGE(PG8_SB(1, 1), b3 + hstepB, voffB);
            PG8_WAIT_V(6); PG8_BAR; PG8_MMA(1, 1, At, B1); PG8_BAR;
        }
        E(acc, cur, wr, wc, fr, fq);
        if (!has_next) break;
#pragma unroll
        for (int a = 0; a < 2; ++a)
#pragma unroll
            for (int b = 0; b < 2; ++b)
#pragma unroll
                for (int m = 0; m < 4; ++m)
#pragma unroll
                    for (int n = 0; n < 2; ++n) acc[a][b][m][n] = (f32x4){0.f, 0.f, 0.f, 0.f};
        cur = nxt; cA = nA; cB = nB; ++ui;
    }
    PG8_WAIT_V(0);
    if (wr == 0) PG8_BAR;
    PG8_BAR;
#undef PG8_SA
#undef PG8_SB
#undef PG8_STAGE
#undef PG8_LDA
#undef PG8_LDB
#undef PG8_MMA
#undef PG8_WAIT_V
#undef PG8_WAIT_L
#undef PG8_BAR
#undef PG8_SCHED
}

struct SchedPlain : TileMap {
    const char* A; const char* B; size_t tstepA, tstepB; int nt;
    __device__ bool next(int i, Unit& u) const { int pm, pn; if (!tile((long)i * G + c, pm, pn)) return false;
        u.pm = pm; u.pn = pn; u.a = A + (size_t)pm * tstepA; u.b = B + (size_t)pn * tstepB; u.nt = nt; u.aux = 0; return true; }
};
struct SchedMerge : TileMap {
    const char* Y; const char* WP;
    __device__ bool next(int i, Unit& u) const { const int ti = i / 3, seg = i - ti * 3; int pm, pn; if (!tile((long)ti * G + c, pm, pn)) return false;
        const int koff = seg == 0 ? 0 : (seg == 1 ? 512 : 1024);
        u.pm = pm; u.pn = pn; u.a = Y + ((size_t)pm * 256 * YLD + koff) * 2; u.b = WP + ((size_t)pn * 256 * YLD + koff) * 2; u.nt = seg == 2 ? 4 : 8; u.aux = seg; return true; }
};
struct SchedDft {
    const char* DM; const char* FT; int G, c;
    __device__ bool next(int i, Unit& u) const { const int x = i * G + c; if (x >= 272) return false;
        if (x < 256) { const int b = x >> 5, rem = x & 31, pm = rem >> 1, h = rem & 1;
            u.a = DM + ((size_t)pm * 256 * DMLD + 4096 * h) * 2; u.b = FT + ((size_t)(b * 512 + 256 * h) * FTLD) * 2; u.nt = 64; u.pm = b * 16 + pm; u.pn = h; }
        else { const int cu = x - 256, b = cu >> 1, h = cu & 1;
            u.a = DM + ((size_t)4096 * DMLD + 256 * h) * 2; u.b = FT + ((size_t)(b * 512 + 256 * h) * FTLD + 4096) * 2; u.nt = 4; u.pm = 128 + b; u.pn = h; }
        u.aux = 0; return true; }
};

typedef f32x4 Acc[2][2][4][2];
template <int ACT> __device__ __forceinline__ void store_bf16_tile(const Acc& acc, bf16_t* base, const int ld) {
#pragma unroll
    for (int ai = 0; ai < 2; ++ai)
#pragma unroll
        for (int m = 0; m < 4; ++m) { bf16_t* rowp = base + (size_t)(ai * HALF + m * 16) * ld;
#pragma unroll
            for (int bj = 0; bj < 2; ++bj) { f32x4 v0 = acc[ai][bj][m][0], v1 = acc[ai][bj][m][1];
                if (ACT == 1) {
#pragma unroll
                    for (int j = 0; j < 4; ++j) { v0[j] = gelu_tanh_(v0[j]); v1[j] = gelu_tanh_(v1[j]); } }
                if (ACT == 2) {
#pragma unroll
                    for (int j = 0; j < 4; ++j) { v0[j] = sigmoidf_(v0[j]); v1[j] = sigmoidf_(v1[j]); } }
                u32x4 w; w.x = cvt_pk_bf16(v0[0], v0[1]); w.y = cvt_pk_bf16(v0[2], v0[3]); w.z = cvt_pk_bf16(v1[0], v1[1]); w.w = cvt_pk_bf16(v1[2], v1[3]);
                *(u32x4*)(rowp + bj * HALF) = w; } }
}

struct EpiUp {
    bf16_t* act;
    __device__ __forceinline__ void operator()(const Acc& acc, const Unit& u, int wr, int wc, int fr, int fq) const {
        bf16_t* base = act + (size_t)(u.pm * BM + wr * 64 + fr) * DFF + u.pn * 128 + wc * 32 + 8 * fq;
#pragma unroll
        for (int ai = 0; ai < 2; ++ai)
#pragma unroll
            for (int m = 0; m < 4; ++m) { const f32x4 g0 = acc[ai][0][m][0], g1 = acc[ai][0][m][1], u0 = acc[ai][1][m][0], u1 = acc[ai][1][m][1]; f32x4 v0, v1;
#pragma unroll
                for (int j = 0; j < 4; ++j) { v0[j] = siluf_(g0[j]) * u0[j]; v1[j] = siluf_(g1[j]) * u1[j]; }
                u32x4 w; w.x = cvt_pk_bf16(v0[0], v0[1]); w.y = cvt_pk_bf16(v0[2], v0[3]); w.z = cvt_pk_bf16(v1[0], v1[1]); w.w = cvt_pk_bf16(v1[2], v1[3]);
                *(u32x4*)(base + (size_t)(ai * HALF + m * 16) * DFF) = w; }
    }
};
struct EpiRes {
    const float* in_lat; const float* in_ctx; float* out_lat; float* out_ctx; const float* modv; float mult;
    __device__ __forceinline__ void operator()(const Acc& acc, const Unit& u, int wr, int wc, int fr, int fq) const {
        const bool lat = u.pm < 128; const int bidx = lat ? (u.pm >> 4) : 8;
        const int colo = u.pn * BM + wc * 32 + 8 * fq;
        const float* sv = modv + (size_t)bidx * 9216 + colo;
        f32x4 s[2][2];
#pragma unroll
        for (int bj = 0; bj < 2; ++bj)
#pragma unroll
            for (int n = 0; n < 2; ++n) s[bj][n] = *(const f32x4*)(sv + bj * HALF + 4 * n) * mult;
        const size_t rowl = (size_t)((lat ? u.pm : u.pm - 128) * BM + wr * 64 + fr);
        const float* ip = (lat ? in_lat : in_ctx) + rowl * D + colo; float* op = (lat ? out_lat : out_ctx) + rowl * D + colo;
#pragma unroll
        for (int ai = 0; ai < 2; ++ai)
#pragma unroll
            for (int m = 0; m < 4; ++m) { const size_t off = (size_t)(ai * HALF + m * 16) * D;
#pragma unroll
                for (int bj = 0; bj < 2; ++bj)
#pragma unroll
                    for (int n = 0; n < 2; ++n) { f32x4 r = *(const f32x4*)(ip + off + bj * HALF + 4 * n); r += s[bj][n] * acc[ai][bj][m][n]; *(f32x4*)(op + off + bj * HALF + 4 * n) = r; }
                asm volatile("" ::: "memory"); }
    }
};
struct EpiIn {
    bf16_t* FT; bf16_t* XL; bf16_t* GG; bf16_t* SCB; bf16_t* CX; bf16_t* GATE;
    __device__ __forceinline__ void operator()(const Acc& acc, const Unit& u, int wr, int wc, int fr, int fq) const {
        const int pn = u.pn; const size_t row0 = (size_t)(u.pm * BM + wr * 64 + fr); const int cw = wc * 32 + 8 * fq;
        if (pn >= 9) { store_bf16_tile<2>(acc, GATE + row0 * 3072 + (pn - 9) * 256 + cw, 3072); }
        else if (pn < 2) {
            const bool lat = u.pm < 128; const int b = lat ? (u.pm >> 4) : (u.pm - 128); const int tok0 = (lat ? (u.pm & 15) * 256 : 4096) + wr * 64 + fr;
            bf16_t* base = FT + ((size_t)(b * 512 + pn * 256 + cw) * FTLD) + tok0;
#pragma unroll
            for (int ai = 0; ai < 2; ++ai)
#pragma unroll
                for (int m = 0; m < 4; ++m)
#pragma unroll
                    for (int bj = 0; bj < 2; ++bj)
#pragma unroll
                        for (int n = 0; n < 2; ++n) { const f32x4 v = acc[ai][bj][m][n]; const unsigned w0 = cvt_pk_bf16(v[0], v[1]), w1 = cvt_pk_bf16(v[2], v[3]);
                            bf16_t* p = base + (size_t)(bj * HALF + 4 * n) * FTLD + ai * HALF + m * 16;
                            p[0] = (bf16_t)(w0 & 0xffffu); p[FTLD] = (bf16_t)(w0 >> 16); p[2 * FTLD] = (bf16_t)(w1 & 0xffffu); p[3 * FTLD] = (bf16_t)(w1 >> 16); asm volatile("" ::: "memory"); }
        }
        else if (pn < 4) { store_bf16_tile<0>(acc, XL + row0 * 512 + (pn - 2) * 256 + cw, 512); }
        else if (pn < 6) { store_bf16_tile<1>(acc, GG + row0 * 512 + (pn - 4) * 256 + cw, 512); }
        else if (pn == 6) { store_bf16_tile<0>(acc, SCB + row0 * 256 + cw, 256); }
        else {
            bf16_t* base = CX + row0 * 256 + (pn - 7) * 128 + cw;
#pragma unroll
            for (int ai = 0; ai < 2; ++ai)
#pragma unroll
                for (int m = 0; m < 4; ++m) { const f32x4 v0 = acc[ai][0][m][0] * acc[ai][1][m][0], v1 = acc[ai][0][m][1] * acc[ai][1][m][1];
                    u32x4 w; w.x = cvt_pk_bf16(v0[0], v0[1]); w.y = cvt_pk_bf16(v0[2], v0[3]); w.z = cvt_pk_bf16(v1[0], v1[1]); w.w = cvt_pk_bf16(v1[2], v1[3]);
                    *(u32x4*)(base + (size_t)(ai * HALF + m * 16) * 256) = w; }
        }
    }
};
struct EpiY {
    bf16_t* Y;
    __device__ __forceinline__ void operator()(const Acc& acc, const Unit& u, int wr, int wc, int fr, int fq) const {
#ifdef ZHALF
        if (u.pn == ZHALF) { Acc z;
#pragma unroll
            for (int a = 0; a < 2; ++a)
#pragma unroll
                for (int b = 0; b < 2; ++b)
#pragma unroll
                    for (int m = 0; m < 4; ++m)
#pragma unroll
                        for (int n = 0; n < 2; ++n) z[a][b][m][n] = (f32x4){0.f, 0.f, 0.f, 0.f};
            store_bf16_tile<0>(z, Y + (size_t)(u.pm * BM + wr * 64 + fr) * YLD + u.pn * 256 + wc * 32 + 8 * fq, YLD); return; }
#endif
        store_bf16_tile<0>(acc, Y + (size_t)(u.pm * BM + wr * 64 + fr) * YLD + u.pn * 256 + wc * 32 + 8 * fq, YLD);
    }
};
struct EpiMerge {
    const bf16_t* GATE; bf16_t* Mb;
    __device__ __forceinline__ void operator()(const Acc& acc, const Unit& u, int wr, int wc, int fr, int fq) const {
        const int seg = u.aux; const size_t row0 = (size_t)(u.pm * BM + wr * 64 + fr); const int col0 = u.pn * BM + wc * 32 + 8 * fq;
        const bf16_t* gp = GATE + row0 * 3072 + seg * 1024 + col0; bf16_t* mp = Mb + row0 * D + col0;
#ifdef MINV
        if (seg != 0) { asm volatile("s_waitcnt vmcnt(0)" ::: "memory"); __builtin_amdgcn_fence(__ATOMIC_ACQUIRE, "agent"); asm volatile("s_waitcnt vmcnt(0)" ::: "memory"); }
#endif
#pragma unroll
        for (int ai = 0; ai < 2; ++ai)
#pragma unroll
            for (int m = 0; m < 4; ++m)
#pragma unroll
                for (int bj = 0; bj < 2; ++bj) { const size_t ro = (size_t)(ai * HALF + m * 16);
                    const u32x4 g = *(const u32x4*)(gp + ro * 3072 + bj * HALF);
                    const f32x4 a0 = acc[ai][bj][m][0], a1 = acc[ai][bj][m][1];
                    float zb_ = 1.0f;
#ifdef ZB
                    if (seg == ZB) zb_ = 0.0f;
#endif
#ifdef BRI
                    if (seg == BRI) zb_ = BRS;
#endif
                    float o[8] = {bflo(g.x) * a0[0], bfhi(g.x) * a0[1], bflo(g.y) * a0[2], bfhi(g.y) * a0[3], bflo(g.z) * a1[0], bfhi(g.z) * a1[1], bflo(g.w) * a1[2], bfhi(g.w) * a1[3]};
#pragma unroll
                    for (int q_ = 0; q_ < 8; ++q_) o[q_] *= zb_;
                    if (seg != 0) { const u32x4 p = *(const u32x4*)(mp + ro * D + bj * HALF);
                        o[0] += bflo(p.x); o[1] += bfhi(p.x); o[2] += bflo(p.y); o[3] += bfhi(p.y); o[4] += bflo(p.z); o[5] += bfhi(p.z); o[6] += bflo(p.w); o[7] += bfhi(p.w); }
                    u32x4 w; w.x = cvt_pk_bf16(o[0], o[1]); w.y = cvt_pk_bf16(o[2], o[3]); w.z = cvt_pk_bf16(o[4], o[5]); w.w = cvt_pk_bf16(o[6], o[7]);
                    *(u32x4*)(mp + ro * D + bj * HALF) = w; asm volatile("" ::: "memory"); }
    }
};
}

__device__ __forceinline__ void norm_phase(const float* in_lat, const float* in_ctx, const float* gvec, const float* mshift, const float* mscale, bf16_t* outb, int nrows) {
    const int tx = otid(), wave = tx >> 6, lane = tx & 63;
    for (int row = blockIdx.x * 8 + wave; row < nrows; row += gridDim.x * 8) {
        const float* src = row < MLAT ? in_lat + (size_t)row * D : in_ctx + (size_t)(row - MLAT) * D;
        f32x4 v[4]; float ss = 0.f;
#pragma unroll
        for (int i = 0; i < 4; ++i) { v[i] = *(const f32x4*)(src + i * 256 + lane * 4); ss += v[i][0] * v[i][0] + v[i][1] * v[i][1] + v[i][2] * v[i][2] + v[i][3] * v[i][3]; }
#pragma unroll
        for (int o = 32; o >= 1; o >>= 1) ss += __shfl_xor(ss, o);
        const float rstd = rsqrtf(ss * (1.0f / D) + 1e-6f);
        const int bidx = row < MLAT ? (row >> 12) : 8;
#pragma unroll
        for (int i = 0; i < 4; ++i) { const int col = i * 256 + lane * 4;
            const f32x4 g = *(const f32x4*)(gvec + col), sc = *(const f32x4*)(mscale + (size_t)bidx * 9216 + col), sh = *(const f32x4*)(mshift + (size_t)bidx * 9216 + col);
            const f32x4 y = v[i] * rstd * g; const f32x4 o = y * (sc + 1.0f) + sh;
            u32x2 w; w.x = cvt_pk_bf16(o[0], o[1]); w.y = cvt_pk_bf16(o[2], o[3]);
            *(u32x2*)(outb + (size_t)row * D + col) = w; }
    }
}
__device__ __forceinline__ void final_norm_phase(float* io, const float* gvec) {
    const int tx = otid(), wave = tx >> 6, lane = tx & 63;
    for (int row = blockIdx.x * 8 + wave; row < MLAT; row += gridDim.x * 8) {
        float* src = io + (size_t)row * D;
        f32x4 v[4]; float ss = 0.f;
#pragma unroll
        for (int i = 0; i < 4; ++i) { v[i] = *(const f32x4*)(src + i * 256 + lane * 4); ss += v[i][0] * v[i][0] + v[i][1] * v[i][1] + v[i][2] * v[i][2] + v[i][3] * v[i][3]; }
#pragma unroll
        for (int o = 32; o >= 1; o >>= 1) ss += __shfl_xor(ss, o);
        const float rstd = rsqrtf(ss * (1.0f / D) + 1e-6f);
        float msk = 1.0f;
#if defined(MASKT)
        { const int t = row & 4095, bb = row >> 12; (void)bb;
          if (MASKT == 1 && ((t & 63) < 2 || (t & 63) >= 62)) msk = 0.f;
          if (MASKT == 2 && t < 256) msk = 0.f;
          if (MASKT == 3 && t >= 3840) msk = 0.f;
          if (MASKT == 4 && bb == 0) msk = 0.f;
          if (MASKT == 5 && (t & 63) >= 48) msk = 0.f;
          if (MASKT == 6 && (t & 63) < 16) msk = 0.f; }
#endif
#pragma unroll
        for (int i = 0; i < 4; ++i) { const int col = i * 256 + lane * 4; const f32x4 g = *(const f32x4*)(gvec + col); *(f32x4*)(src + col) = v[i] * (rstd * msk) * g; }
    }
}

__device__ __forceinline__ void load_tile_128x64(LAS float* T, const float* src, int ldsrc, int k0, int n0) {
    const int tid = otid(), j = tid & 63, i0 = tid >> 6;
    float v[16];
#pragma unroll
    for (int ii = 0; ii < 16; ++ii) v[ii] = src[(size_t)(k0 + i0 + 8 * ii) * ldsrc + n0 + j];
#pragma unroll
    for (int ii = 0; ii < 16; ++ii) T[(i0 + 8 * ii) * 65 + j] = v[ii];
}
__device__ __forceinline__ void cvt_tile(LAS float* T, const float* src, int ldsrc, int k0, int n0, bf16_t* dst, int ldd, int drow0, int dk0) {
    load_tile_128x64(T, src, ldsrc, k0, n0);
    __syncthreads();
    const int tid = otid(), ip = tid & 63, j0 = tid >> 6;
#pragma unroll
    for (int jj = 0; jj < 8; ++jj) { const int j = j0 + 8 * jj; const float lo = T[(2 * ip) * 65 + j], hi = T[(2 * ip + 1) * 65 + j];
        *(unsigned*)(dst + (size_t)(drow0 + j) * ldd + dk0 + 2 * ip) = cvt_pk_bf16(lo, hi); }
    __syncthreads();
}
__device__ __forceinline__ void convert_layer(const PT P, int l, LAS unsigned char* lds) {
    LAS float* T = (LAS float*)lds;
    unsigned char* ws = P.ws();
    bf16_t* WGU = (bf16_t*)(ws + WS_WGU); bf16_t* WD = (bf16_t*)(ws + WS_WD); bf16_t* WIN = (bf16_t*)(ws + WS_WIN); bf16_t* WP = (bf16_t*)(ws + WS_WP); bf16_t* WOUT = (bf16_t*)(ws + WS_WOUT);
    for (int task = blockIdx.x; task < 3040; task += gridDim.x) {
        int t = task; const float* win = P.in(12) + (size_t)l * D * INC;
        if (t < 1408) {
            const int which = t / 352, r = t % 352, kt = r / 44, ntile = r % 44, f = which & 1, isup = which >> 1;
            const float* src = (isup ? P.in(10) : P.in(9)) + (size_t)(l * 2 + f) * D * DFF;
            const int n0 = ntile * 64, drow0 = (n0 >> 7) * 256 + isup * 128 + (n0 & 127);
            cvt_tile(T, src, DFF, kt * 128, n0, WGU + (size_t)f * NGU * D, D, drow0, kt * 128);
            continue; }
        t -= 1408;
        if (t < 704) {
            const int f = t / 352, r = t % 352, kt = r / 16, ntile = r % 16;
            const float* src = P.in(11) + (size_t)(l * 2 + f) * DFF * D;
            cvt_tile(T, src, D, kt * 128, ntile * 64, WD + (size_t)f * D * DFF, DFF, ntile * 64, kt * 128);
            continue; }
        t -= 704;
        if (t < 608) {
            const int kt = t / 76, ntile = t % 76, n = 256 + ntile * 64; int drow0;
            if (n < 768) drow0 = 512 + (n - 256);
            else if (n < 1280) drow0 = 1024 + (n - 768);
            else if (n < 1536) drow0 = 1536 + (n - 1280);
            else if (n < 1792) { const int q = n - 1536; drow0 = 1792 + (q >> 7) * 256 + (q & 127); }
            else if (n < 2048) { const int q = n - 1792; drow0 = 1792 + (q >> 7) * 256 + 128 + (q & 127); }
            else drow0 = 2304 + (n - 2048);
            cvt_tile(T, win, INC, kt * 128, n, WIN, D, drow0, kt * 128);
            continue; }
        t -= 608;
        if (t < 64) {
            const int dup = t / 32, r = t % 32, kt = r / 16, ntile = r % 16;
            cvt_tile(T, P.in(21) + (size_t)l * 256 * D, D, kt * 128, ntile * 64, WP, YLD, ntile * 64, dup * 256 + kt * 128);
            continue; }
        t -= 64;
        if (t < 64) {
            const int kt = t / 16, ntile = t % 16;
            cvt_tile(T, P.in(22) + (size_t)l * 512 * D, D, kt * 128, ntile * 64, WP, YLD, ntile * 64, 512 + kt * 128);
            continue; }
        t -= 64;
        if (t < 32) {
            const int kt = t / 16, ntile = t % 16;
            cvt_tile(T, P.in(23) + (size_t)l * 256 * D, D, kt * 128, ntile * 64, WP, YLD, ntile * 64, 1024 + kt * 128);
            continue; }
        t -= 32;
        if (t < 128) {
            const int kt = t / 16, ntile = t % 16;
            cvt_tile(T, P.in(24) + (size_t)l * D * D, D, kt * 128, ntile * 64, WOUT, D, ntile * 64, kt * 128);
            continue; }
        t -= 128;
        {
            const int g = t / 8, kt = t % 8;
            load_tile_128x64(T, win, INC, kt * 128, 64 * g);
            LAS float* ct = T + 128 * 65; LAS float* st = ct + 64;
            const int tx = otid();
            if (tx < 64) { ct[tx] = cospif((float)tx * (1.0f / 32.0f)); st[tx] = sinpif((float)tx * (1.0f / 32.0f)); }
            __syncthreads();
            const int k = tx & 127, mg = tx >> 7;
            for (int mi = 0; mi < 16; ++mi) { const int m = mg * 16 + mi; float cs = 0.f, sn = 0.f;
#pragma unroll 8
                for (int j = 0; j < 64; ++j) { const float w = T[k * 65 + j]; const int q = (j * m) & 63; cs += w * ct[q]; sn += w * st[q]; }
                WIN[(size_t)(64 * g + m) * D + kt * 128 + k] = (bf16_t)(cvt_pk_bf16(cs, 0.f) & 0xffffu);
                WIN[(size_t)(256 + 64 * g + m) * D + kt * 128 + k] = (bf16_t)(cvt_pk_bf16(sn, 0.f) & 0xffffu); }
            __syncthreads();
        }
    }
}

__device__ __forceinline__ void prep_phase(const PT P, LAS unsigned char* lds) {
    LAS float* sl = (LAS float*)lds;
#ifdef SELFCHK
    if (blockIdx.x == 0 && threadIdx.x < 64) ((float*)(P.ws() + WS_FLAGS))[threadIdx.x] = threadIdx.x == 45 ? __int_as_float(0x7fffffff) : 0.f;
#endif
    float* mods = (float*)(P.ws() + WS_MODS); const float* cc = P.in(1); const float* cx_ = P.in(3);
    const int tx = otid();
    for (int idx = tx; idx < 9216; idx += 512) { const int b = idx >> 10, k = idx & 1023; const float v = b < 8 ? cc[b * 1024 + k] : cx_[k]; sl[idx] = v / (1.0f + expf(-v)); }
    __syncthreads();
    LAS float* red = (LAS float*)(lds + 40960);
    for (int task = blockIdx.x; task < 288; task += gridDim.x) {
        const int l = task / 72, cb = task % 72, cj = tx & 127, kq = tx >> 7; const int col = cb * 128 + cj;
        float acc[9];
#pragma unroll
        for (int b = 0; b < 9; ++b) acc[b] = 0.f;
        const float* wp = P.in(4) + ((size_t)l * 1024 + kq * 256) * 9216 + col;
#pragma unroll 8
        for (int k = 0; k < 256; ++k) { const float w = wp[(size_t)k * 9216];
#pragma unroll
            for (int b = 0; b < 9; ++b) acc[b] += sl[b * 1024 + kq * 256 + k] * w; }
#pragma unroll
        for (int b = 0; b < 9; ++b) red[(kq * 9 + b) * 128 + cj] = acc[b];
        __syncthreads();
        if (tx < 128) { const float bias = P.in(5)[l * 9216 + col];
#pragma unroll
            for (int b = 0; b < 9; ++b) mods[(size_t)(l * 9 + b) * 9216 + col] = ((red[(0 * 9 + b) * 128 + cj] + red[(1 * 9 + b) * 128 + cj]) + (red[(2 * 9 + b) * 128 + cj] + red[(3 * 9 + b) * 128 + cj])) + bias; }
        __syncthreads();
    }
    bf16_t* DM = (bf16_t*)(P.ws() + WS_DMAT);
    const int nthr = gridDim.x * 512;
    for (int it = blockIdx.x * 512 + tx; it < 4096 * 1024; it += nthr) {
        const int k = it >> 10, n0 = (it & 1023) * 8; float v[8];
#pragma unroll
        for (int e = 0; e < 8; ++e) { const int n = n0 + e, nn = n & 4095, idx = (k * nn) & 4095; const float x = (float)idx * (1.0f / 2048.0f);
            v[e] = (n < 4096 ? cospif(x) : -sinpif(x)) * (1.0f / 512.0f); }
        u32x4 w; w.x = cvt_pk_bf16(v[0], v[1]); w.y = cvt_pk_bf16(v[2], v[3]); w.z = cvt_pk_bf16(v[4], v[5]); w.w = cvt_pk_bf16(v[6], v[7]);
        *(u32x4*)(DM + (size_t)k * DMLD + n0) = w;
    }
    for (int it = blockIdx.x * 512 + tx; it < 256 * 64; it += nthr) {
        const int k = it >> 6, n0 = (it & 63) * 8; float v[8];
#pragma unroll
        for (int e = 0; e < 8; ++e) { const int n = n0 + e, nn = n & 255, idx = (k * nn) & 255; const float x = (float)idx * (1.0f / 128.0f);
            v[e] = (n < 256 ? cospif(x) : -sinpif(x)) * (1.0f / 128.0f); }
        u32x4 w; w.x = cvt_pk_bf16(v[0], v[1]); w.y = cvt_pk_bf16(v[2], v[3]); w.z = cvt_pk_bf16(v[4], v[5]); w.w = cvt_pk_bf16(v[6], v[7]);
        *(u32x4*)(DM + (size_t)(4096 + k) * DMLD + n0) = w;
    }
    __syncthreads();
}

struct ScanArgs { const float* cw; const float* cb; const float* wa; const float* ba; const float* wx; const float* bx; const float* lam; const float* scw;
                  const bf16_t* XL; const bf16_t* GG; const bf16_t* SCB; const bf16_t* CX; bf16_t* Y; float* agg; };

template <bool PASS2, int DIR>
__device__ __forceinline__ void scan_dir(const ScanArgs& A, LAS float* T, int blk, bool lat, int b, int j, int row0, const int c) {
    const int head = c >> 6, cl = c & 63;
    const float sp8 = 8.0f * log1pf(expf(-A.lam[DIR * 512 + c]));
    const float ba_c = A.ba[(DIR * 8 + head) * 64 + cl], bx_c = A.bx[(DIR * 8 + head) * 64 + cl];
    const float* Wa = A.wa + (size_t)((DIR * 8 + head) * 64) * 64 + cl; const float* Wx = A.wx + (size_t)((DIR * 8 + head) * 64) * 64 + cl;
    float h = 0.f, Ap = 1.f;
    if (PASS2) {
        const float* ag = A.agg + DIR * 1024 + c;
        if (DIR == 0) {
#if defined(LRUT) && LRUT == 3
            if (lat) {
#else
            if (lat) { for (int q = 0; q < 4; ++q) { const float* p = ag + (size_t)(512 + b * 4 + q) * 2048; h = p[0] * h + p[512]; }
#endif
                       for (int q = 0; q < j; ++q) { const float* p = ag + (size_t)(b * 64 + q) * 2048; h = p[0] * h + p[512]; } }
            else { for (int q = 0; q < j; ++q) { const float* p = ag + (size_t)(512 + b * 4 + q) * 2048; h = p[0] * h + p[512]; } }
        } else {
#if defined(LRUT) && LRUT == 3
            if (lat) {
#else
            if (lat) { for (int q = 3; q >= 0; --q) { const float* p = ag + (size_t)(512 + b * 4 + q) * 2048; h = p[0] * h + p[512]; }
#endif
                       for (int q = 63; q > j; --q) { const float* p = ag + (size_t)(b * 64 + q) * 2048; h = p[0] * h + p[512]; } }
            else { for (int q = 3; q > j; --q) { const float* p = ag + (size_t)(512 + b * 4 + q) * 2048; h = p[0] * h + p[512]; } }
        }
    }
#ifdef CARRYS
    if (PASS2) h *= CARRYS;
#endif
    for (int tgi = 0; tgi < 4; ++tgi) {
        const int tg = DIR == 0 ? tgi : 3 - tgi;
        float zr[16], zi[16];
#pragma unroll
        for (int tt = 0; tt < 16; ++tt) { zr[tt] = ba_c; zi[tt] = bx_c; }
        const LAS float* Tb = T + (tg * 16) * 512 + head * 64;
#pragma unroll 2
        for (int k = 0; k < 64; k += 4) {
            float wa[4], wx[4];
#pragma unroll
            for (int kk = 0; kk < 4; ++kk) { wa[kk] = Wa[(k + kk) * 64]; wx[kk] = Wx[(k + kk) * 64]; }
#pragma unroll
            for (int tt = 0; tt < 16; ++tt) { const f32x4 xv = *(const LAS f32x4*)(Tb + tt * 512 + k);
                zr[tt] += xv[0] * wa[0] + xv[1] * wa[1] + xv[2] * wa[2] + xv[3] * wa[3];
                zi[tt] += xv[0] * wx[0] + xv[1] * wx[1] + xv[2] * wx[2] + xv[3] * wx[3]; }
        }
#pragma unroll
        for (int tti = 0; tti < 16; ++tti) {
            const int tt = DIR == 0 ? tti : 15 - tti; const int t = tg * 16 + tt;
            const float r = sigmoidf_(zr[tt]), ig = sigmoidf_(zi[tt]);
            const float la = -sp8 * r, a = __expf(la), x2 = 2.0f * la;
            const float ser = -x2 * (1.0f + x2 * 0.5f * (1.0f + x2 * (1.0f / 3.0f) * (1.0f + x2 * 0.25f * (1.0f + x2 * 0.2f * (1.0f + x2 * (1.0f / 6.0f))))));
            const float om = x2 > -0.3f ? ser : 1.0f - __expf(x2);
            const float bt = sqrtf(om) * ig * T[t * 512 + c];
            h = a * h + bt;
            if (!PASS2) Ap *= a;
            else {
                bf16_t* yp = A.Y + (size_t)(row0 + t) * YLD + 512 + c;
#if defined(LRUT) && LRUT == 1
                const float hsel = DIR == 0 ? 0.f : h;
#elif defined(LRUT) && LRUT == 2
                const float hsel = DIR == 0 ? h : 0.f;
#else
                const float hsel = h;
#endif
                if (DIR == 0) *yp = (bf16_t)(cvt_pk_bf16(hsel, 0.f) & 0xffffu);
                else { const float hf = bf2f(*yp), gg = bf2f(A.GG[(size_t)(row0 + t) * 512 + c]); *yp = (bf16_t)(cvt_pk_bf16((hf + hsel) * gg, 0.f) & 0xffffu); }
            }
        }
    }
    if (!PASS2) { float* ag = A.agg + (size_t)blk * 2048 + DIR * 1024 + c; ag[0] = Ap; ag[512] = h; }
}

template <bool PASS2>
__device__ void scan_phase(const ScanArgs& A, LAS unsigned char* lds) {
    LAS float* T = (LAS float*)lds;
    const int c = otid();
    for (int blk = blockIdx.x; blk < NCHUNK; blk += gridDim.x) {
        const bool lat = blk < 512; const int b = lat ? (blk >> 6) : ((blk - 512) >> 2), j = lat ? (blk & 63) : ((blk - 512) & 3);
        const int seq0 = lat ? b * SEQ : MLAT + b * CTX, seqlen = lat ? SEQ : CTX, row0 = seq0 + j * 64, tl0 = j * 64;
        {
            const float w0 = A.cw[c], w1 = A.cw[512 + c], w2 = A.cw[1024 + c], w3 = A.cw[1536 + c], bias = A.cb[c];
            const bf16_t* xp = A.XL + (size_t)row0 * 512 + c;
            float xm2 = tl0 >= 2 ? bf2f(xp[-2 * 512]) : 0.f, xm1 = tl0 >= 1 ? bf2f(xp[-512]) : 0.f, x0 = bf2f(xp[0]);
#pragma unroll 8
            for (int t = 0; t < 64; ++t) { const float xp1 = (tl0 + t + 1 < seqlen) ? bf2f(xp[(size_t)(t + 1) * 512]) : 0.f;
                T[t * 512 + c] = w0 * xm2 + w1 * xm1 + w2 * x0 + w3 * xp1 + bias; xm2 = xm1; xm1 = x0; x0 = xp1; }
        }
        if (!PASS2) {
            const int c2 = c & 255, th = c >> 8;
            float w0 = A.scw[c2], w1 = A.scw[256 + c2], w2 = A.scw[512 + c2];
#if defined(SCTAP)
            if (SCTAP == 0) w0 = 0.f; if (SCTAP == 1) w1 = 0.f; if (SCTAP == 2) w2 = 0.f;
#endif
            for (int t = th * 32; t < th * 32 + 32; ++t) { const int tl = tl0 + t; const size_t row = (size_t)(row0 + t);
                const bool hasl = lat ? (t > 0) : (tl > 0), hasr = lat ? (t < 63) : (tl < CTX - 1);
                const float xl_ = hasl ? bf2f(A.CX[(row - 1) * 256 + c2]) : 0.f, xc_ = bf2f(A.CX[row * 256 + c2]), xr_ = hasr ? bf2f(A.CX[(row + 1) * 256 + c2]) : 0.f;
                const float v = bf2f(A.SCB[row * 256 + c2]) * (w0 * xl_ + w1 * xc_ + w2 * xr_);
                A.Y[row * YLD + 1024 + c2] = (bf16_t)(cvt_pk_bf16(v, 0.f) & 0xffffu); }
        }
        __syncthreads();
        scan_dir<PASS2, 0>(A, T, blk, lat, b, j, row0, c);
        if (PASS2) asm volatile("s_waitcnt vmcnt(0)" ::: "memory");
        scan_dir<PASS2, 1>(A, T, blk, lat, b, j, row0, c);
        __syncthreads();
    }
}

__global__ void __launch_bounds__(512, 2) hybrid_fwd(Params Pk) {
    extern __shared__ __attribute__((aligned(16))) unsigned char shm[];
    LAS unsigned char* lds = (LAS unsigned char*)shm;
    cg::grid_group grid = cg::this_grid();
    {
        LAS unsigned long long* t64 = (LAS unsigned long long*)(lds + PT_OFF);
        const int tx = otid();
        if (tx == 0) {
#pragma unroll
            for (int k = 0; k < 26; ++k) t64[k] = (unsigned long long)Pk.in[k];
            t64[26] = (unsigned long long)Pk.out; t64[27] = (unsigned long long)Pk.ws; }
        __syncthreads();
    }
    const PT P{(LAS const unsigned*)(lds + PT_OFF)};
    const int G = gridDim.x, cid = blockIdx.x;
#ifndef PHM
#define PHM 0xffff
#endif
#define PH(k) if ((PHM >> (k)) & 1)
#define GRID_SYNC() do { asm volatile("s_waitcnt vmcnt(0) lgkmcnt(0)" ::: "memory"); __builtin_amdgcn_fence(__ATOMIC_RELEASE, "agent"); asm volatile("s_waitcnt vmcnt(0)" ::: "memory"); grid.sync(); __builtin_amdgcn_fence(__ATOMIC_ACQUIRE, "agent"); asm volatile("s_waitcnt vmcnt(0)" ::: "memory"); } while (0)
#define MODS(ws_, l_) ((const float*)((ws_) + WS_MODS) + (size_t)(l_) * 9 * 9216)

    PH(0) prep_phase(P, lds);
    GRID_SYNC();

    for (int l = 0; l < DEPTH; ++l) {
        PH(1) { unsigned char* ws = P.ws(); const float* ml = MODS(ws, l);
            norm_phase(l == 0 ? P.in(0) : P.out(), l == 0 ? P.in(2) : (const float*)(ws + WS_HCTX), P.in(6) + l * D, ml + 0 * 1024, ml + 1 * 1024, (bf16_t*)(ws + WS_ABUF), MTOT); }
        PH(2) convert_layer(P, l, lds);
        GRID_SYNC();
        for (int f = 0; f < 2; ++f) {
            if (f == 1) { PH(1) { unsigned char* ws = P.ws(); const float* ml = MODS(ws, l);
                norm_phase(P.out(), (const float*)(ws + WS_HCTX), P.in(8) + l * D, ml + 6 * 1024, ml + 7 * 1024, (bf16_t*)(ws + WS_ABUF), MTOT); } GRID_SYNC(); }
            PH(3) { unsigned char* ws = P.ws(); pg8::SchedPlain S; S.init(136, 22, G, cid); S.A = (const char*)(ws + WS_ABUF); S.B = (const char*)(ws + WS_WGU) + (size_t)f * NGU * D * 2; S.tstepA = (size_t)256 * D * 2; S.tstepB = (size_t)256 * D * 2; S.nt = D / 64;
              pg8::EpiUp E{(bf16_t*)(ws + WS_ACT)}; pg8::gemm_phase(lds, D, D, S, E); }
            GRID_SYNC();
#ifdef SELFCHK
            if (l == 0 && f == 0 && blockIdx.x == 0) {
                unsigned char* ws = P.ws(); const bf16_t* Ab = (const bf16_t*)(ws + WS_ABUF); const bf16_t* Ac = (const bf16_t*)(ws + WS_ACT); float* fl = (float*)(ws + WS_FLAGS);
                const float* wg = P.in(9); const float* wu = P.in(10); const int tx = otid();
                const int row = (tx * 7919 + 13) % MTOT, j = (tx * 104729 + 7) % DFF; float dg = 0.f, du = 0.f;
                for (int k = 0; k < D; ++k) { const float a = bf2f(Ab[(size_t)row * D + k]); dg += a * wg[(size_t)k * DFF + j]; du += a * wu[(size_t)k * DFF + j]; }
                const float ex = siluf_(dg) * du, got = bf2f(Ac[(size_t)row * DFF + j]);
                if (fabsf(got - ex) > 0.03f * fabsf(ex) + 0.05f) fl[4] = 1.f;
            }
#endif
            PH(4) { unsigned char* ws = P.ws(); pg8::SchedPlain S; S.init(136, 4, G, cid); S.A = (const char*)(ws + WS_ACT); S.B = (const char*)(ws + WS_WD) + (size_t)f * D * DFF * 2; S.tstepA = (size_t)256 * DFF * 2; S.tstepB = (size_t)256 * DFF * 2; S.nt = DFF / 64;
              const bool first = (l == 0 && f == 0); float* hctx = (float*)(ws + WS_HCTX); float* outp = P.out();
              pg8::EpiRes E{first ? P.in(0) : outp, first ? P.in(2) : hctx, outp, hctx, MODS(ws, l) + (f == 0 ? 2 : 8) * 1024, 0.5f}; pg8::gemm_phase(lds, DFF, DFF, S, E); }
            GRID_SYNC();
            if (f == 1) break;
            PH(1) { unsigned char* ws = P.ws(); const float* ml = MODS(ws, l);
                norm_phase(P.out(), (const float*)(ws + WS_HCTX), P.in(7) + l * D, ml + 3 * 1024, ml + 4 * 1024, (bf16_t*)(ws + WS_ABUF), MTOT); }
            GRID_SYNC();
#if defined(DBG_STAGE) && DBG_STAGE == 8
            if (l == DBG_L) { const bf16_t* Ad = (const bf16_t*)(P.ws() + WS_ABUF); float* o = P.out();
                for (size_t i = (size_t)blockIdx.x * 512 + otid(); i < (size_t)MLAT * 1024; i += (size_t)gridDim.x * 512) o[i] = bf2f(Ad[i]);
                return; }
#endif
            PH(5) { unsigned char* ws = P.ws(); pg8::SchedPlain S; S.init(136, 21, G, cid); S.A = (const char*)(ws + WS_ABUF); S.B = (const char*)(ws + WS_WIN); S.tstepA = (size_t)256 * D * 2; S.tstepB = (size_t)256 * D * 2; S.nt = D / 64;
              pg8::EpiIn E{(bf16_t*)(ws + WS_FT), (bf16_t*)(ws + WS_XL), (bf16_t*)(ws + WS_GG), (bf16_t*)(ws + WS_SCB), (bf16_t*)(ws + WS_CX), (bf16_t*)(ws + WS_GATE)}; pg8::gemm_phase(lds, D, D, S, E); }
            GRID_SYNC();
#if defined(DBG_STAGE) && DBG_STAGE == 7
            if (l == DBG_L) { const bf16_t* Xd = (const bf16_t*)(P.ws() + WS_XL); const bf16_t* Gd = (const bf16_t*)(P.ws() + WS_GG); float* o = P.out();
                for (size_t i = (size_t)blockIdx.x * 512 + otid(); i < (size_t)MLAT * 1024; i += (size_t)gridDim.x * 512) { const size_t r = i >> 10, c_ = i & 1023; o[i] = c_ < 512 ? bf2f(Xd[r * 512 + c_]) : bf2f(Gd[r * 512 + c_ - 512]); }
                return; }
#endif
#ifndef FAILTX
#define FAILTX 0
#endif
#ifndef MINTX
#define MINTX -1
#endif
#ifdef SELFCHK
            if (l == 0 && blockIdx.x == 0) {
                unsigned char* ws = P.ws(); const bf16_t* Ab = (const bf16_t*)(ws + WS_ABUF); float* fl = (float*)(ws + WS_FLAGS); const float* win = P.in(12); const int tx = otid();
                const bf16_t* Wn = (const bf16_t*)(ws + WS_WIN);
                const int row = (tx * 7919 + 13) % MTOT;
                {
                    const int c_ = (tx * 104729 + 7) % 512; float d = 0.f; bool cvbad = false;
                    for (int k = 0; k < D; ++k) { const float w = win[(size_t)k * INC + 256 + c_]; d += bf2f(Ab[(size_t)row * D + k]) * w;
                        const float wb = bf2f(Wn[(size_t)(512 + c_) * D + k]); if (fabsf(wb - w) > 0.01f * fabsf(w) + 1e-6f) cvbad = true; }
                    if (cvbad) fl[1] = 1.f;
                    const float got = bf2f(((const bf16_t*)(ws + WS_XL))[(size_t)row * 512 + c_]);
                    if (fabsf(got - d) > 0.03f * fabsf(d) + 0.05f) fl[2] = 1.f;
                }
                {
                    for (int sidx = 0; sidx < 64; ++sidx) { const unsigned hsh = ((unsigned)tx * 64u + (unsigned)sidx) * 2654435761u;
                        const int drow = 512 + (int)((hsh >> 8) % 4864u), k = (int)(hsh & 1023u); int n;
                        if (drow < 1024) n = 256 + (drow - 512); else if (drow < 1536) n = 768 + (drow - 1024); else if (drow < 1792) n = 1280 + (drow - 1536);
                        else if (drow < 2304) { const int q = drow - 1792, t_ = q >> 8, r_ = q & 255; n = r_ < 128 ? 1536 + t_ * 128 + r_ : 1792 + t_ * 128 + (r_ - 128); }
                        else n = 2048 + (drow - 2304);
                        const float w = win[(size_t)k * INC + n], wb = bf2f(Wn[(size_t)drow * D + k]);
                        if (fabsf(wb - w) > 0.01f * fabsf(w) + 1e-6f) atomicAdd(&fl[40], 1.0f); }
                }
                {
                    const int c_ = (int)(((unsigned)tx * 15485863u + 11u) % 3072u); float d = 0.f;
                    for (int k = 0; k < D; ++k) d += bf2f(Ab[(size_t)row * D + k]) * win[(size_t)k * INC + 2048 + c_];
                    const float got = bf2f(((const bf16_t*)(ws + WS_GATE))[(size_t)row * 3072 + c_]);
                    if (fabsf(got - sigmoidf_(d)) > 0.02f) { fl[3] = 1.f; atomicAdd(&fl[20], 1.0f); atomicAdd(&fl[21 + c_ / 256], 1.0f); if (tx == FAILTX) { fl[41] = (float)c_; fl[42] = (float)row; fl[43] = got; fl[44] = sigmoidf_(d); } if (tx > MINTX) atomicMin((int*)&fl[45], tx + 1000000); if (row >= MLAT) atomicAdd(&fl[46], 1.0f); }
                }
                {
                    const int c_ = (tx * 104729 + 7) % 512; float d = 0.f;
                    for (int k = 0; k < D; ++k) d += bf2f(Ab[(size_t)row * D + k]) * win[(size_t)k * INC + 768 + c_];
                    const float got = bf2f(((const bf16_t*)(ws + WS_GG))[(size_t)row * 512 + c_]); const float ex = gelu_tanh_(d);
                    if (fabsf(got - ex) > 0.03f * fabsf(ex) + 0.05f) fl[5] = 1.f;
                    const int c2 = c_ & 255; float db = 0.f, dc = 0.f, dx = 0.f;
                    for (int k = 0; k < D; ++k) { const float a = bf2f(Ab[(size_t)row * D + k]); db += a * win[(size_t)k * INC + 1280 + c2]; dc += a * win[(size_t)k * INC + 1536 + c2]; dx += a * win[(size_t)k * INC + 1792 + c2]; }
                    const float gb = bf2f(((const bf16_t*)(ws + WS_SCB))[(size_t)row * 256 + c2]), gc = bf2f(((const bf16_t*)(ws + WS_CX))[(size_t)row * 256 + c2]);
                    if (fabsf(gb - db) > 0.03f * fabsf(db) + 0.05f) fl[6] = 1.f;
                    if (fabsf(gc - dc * dx) > 0.04f * fabsf(dc * dx) + 0.08f) fl[7] = 1.f;
                }
            }
#endif
#define SCANARGS(ws_) ScanArgs{P.in(13) + l * 4 * 512, P.in(14) + l * 512, P.in(15) + (size_t)l * 2 * 8 * 64 * 64, P.in(16) + l * 2 * 512, P.in(17) + (size_t)l * 2 * 8 * 64 * 64, P.in(18) + l * 2 * 512, \
                        P.in(19) + l * 2 * 512, P.in(20) + l * 3 * 256, (const bf16_t*)((ws_) + WS_XL), (const bf16_t*)((ws_) + WS_GG), (const bf16_t*)((ws_) + WS_SCB), (const bf16_t*)((ws_) + WS_CX), (bf16_t*)((ws_) + WS_Y), (float*)((ws_) + WS_AGG)}
            PH(6) { unsigned char* ws = P.ws(); const ScanArgs SA = SCANARGS(ws); scan_phase<false>(SA, lds); }
            GRID_SYNC();
#ifdef SELFCHK
            if (l == 0 && blockIdx.x == 0) {
                unsigned char* ws = P.ws(); const bf16_t* Ab = (const bf16_t*)(ws + WS_ABUF); float* fl = (float*)(ws + WS_FLAGS); const float* win = P.in(12); const int tx = otid();
                const int row = (tx * 7919 + 13) % MTOT; const int c_ = (int)(((unsigned)tx * 15485863u + 11u) % 3072u); float d = 0.f;
                for (int k = 0; k < D; ++k) d += bf2f(Ab[(size_t)row * D + k]) * win[(size_t)k * INC + 2048 + c_];
                const float got = bf2f(((const bf16_t*)(ws + WS_GATE))[(size_t)row * 3072 + c_]);
                if (fabsf(got - sigmoidf_(d)) > 0.02f) atomicAdd(&fl[47], 1.0f);
            }
#endif
            PH(7) { unsigned char* ws = P.ws(); const ScanArgs SA = SCANARGS(ws); scan_phase<true>(SA, lds); }
            PH(8) { unsigned char* ws = P.ws(); pg8::SchedDft S{(const char*)(ws + WS_DMAT), (const char*)(ws + WS_FT), G, cid}; pg8::EpiY E{(bf16_t*)(ws + WS_Y)}; pg8::gemm_phase(lds, DMLD, FTLD, S, E); }
            GRID_SYNC();
#if defined(DBG_STAGE) && DBG_STAGE == 1
            if (l == DBG_L) { const bf16_t* Yd = (const bf16_t*)(P.ws() + WS_Y); float* o = P.out();
                for (size_t i = (size_t)blockIdx.x * 512 + otid(); i < (size_t)MLAT * 1024; i += (size_t)gridDim.x * 512) { const size_t r = i >> 10, c_ = i & 1023; o[i] = bf2f(Yd[r * YLD + c_]); }
                return; }
#endif
#if defined(DBG_STAGE) && DBG_STAGE == 2
            if (l == DBG_L) { const bf16_t* Yd = (const bf16_t*)(P.ws() + WS_Y); const bf16_t* Gd = (const bf16_t*)(P.ws() + WS_GATE); float* o = P.out();
                for (size_t i = (size_t)blockIdx.x * 512 + otid(); i < (size_t)MLAT * 1024; i += (size_t)gridDim.x * 512) { const size_t r = i >> 10, c_ = i & 1023; o[i] = c_ < 256 ? bf2f(Yd[r * YLD + 1024 + c_]) : bf2f(Gd[r * 3072 + c_]); }
                return; }
#endif
            PH(9) { unsigned char* ws = P.ws(); pg8::SchedMerge S; S.init(136, 4, G, cid); S.Y = (const char*)(ws + WS_Y); S.WP = (const char*)(ws + WS_WP); pg8::EpiMerge E{(const bf16_t*)(ws + WS_GATE), (bf16_t*)(ws + WS_ABUF)}; pg8::gemm_phase(lds, YLD, YLD, S, E); }
            GRID_SYNC();
#if defined(DBG_STAGE) && DBG_STAGE == 3
            if (l == DBG_L) { const bf16_t* Md = (const bf16_t*)(P.ws() + WS_ABUF); float* o = P.out();
                for (size_t i = (size_t)blockIdx.x * 512 + otid(); i < (size_t)MLAT * 1024; i += (size_t)gridDim.x * 512) o[i] = bf2f(Md[i]);
                return; }
#endif
            PH(10) { unsigned char* ws = P.ws(); pg8::SchedPlain S; S.init(136, 4, G, cid); S.A = (const char*)(ws + WS_ABUF); S.B = (const char*)(ws + WS_WOUT); S.tstepA = (size_t)256 * D * 2; S.tstepB = (size_t)256 * D * 2; S.nt = D / 64;
              float* hctx = (float*)(ws + WS_HCTX); float* outp = P.out();
              pg8::EpiRes E{outp, hctx, outp, hctx, MODS(ws, l) + 5 * 1024, 1.0f}; pg8::gemm_phase(lds, D, D, S, E); }
            GRID_SYNC();
#if defined(DBG_STAGE) && DBG_STAGE == 4
            if (l == 0) return;
#endif
        }
#if defined(DBG_STAGE) && DBG_STAGE == 5
        if (l == 0) return;
#endif
#if defined(DBG_STAGE) && DBG_STAGE == 6
        if (l == 1) return;
#endif
    }
    PH(11) final_norm_phase(P.out(), P.in(25));
#ifdef SELFCHK
    GRID_SYNC();
    { const float* fl = (const float*)(P.ws() + WS_FLAGS); float sc = 1.f;
#if SELFCHK == 1
      for (int q = 1; q < 16; ++q) if (fl[q] != 0.f) sc += (float)(1 << q);
#elif SELFCHK == 2
      sc += fl[20];
#elif SELFCHK == 20
      sc += fl[40];
#elif SELFCHK == 30
      sc += (float)(__float_as_int(fl[45]) - 1000000 - MINTX) * 10.f;
#elif SELFCHK == 36
      sc += fl[47];
#elif SELFCHK == 35
      sc += fl[46];
#elif SELFCHK == 31
      sc += fl[41];
#elif SELFCHK == 32
      sc += fl[42];
#elif SELFCHK == 33
      sc += fl[43] * 1000.f;
#elif SELFCHK == 34
      sc += fl[44] * 1000.f;
#else
      sc += fl[21 + SELFCHK - 3];
#endif
      if (sc != 1.f) { float* o = P.out(); for (size_t i = (size_t)blockIdx.x * 512 + otid(); i < (size_t)MLAT * 1024; i += (size_t)gridDim.x * 512) o[i] *= sc; } }
#endif
}

extern "C" void kernel_launch(void* const* d_in, const int* in_sizes, int n_in, void* d_out, int out_size, void* d_ws, size_t ws_size, hipStream_t stream) {
    static int grid_blocks = 0;
    constexpr size_t kDynLds = pg8::STAGE_BYTES + 256;
    if (!grid_blocks) {
        if (ws_size < WS_END) { fprintf(stderr, "kernel_launch: workspace too small: %zu < %zu\n", ws_size, (size_t)WS_END); grid_blocks = -1; return; }
        int dev = 0, cus = 0, per_cu = 0;
        hipGetDevice(&dev);
        hipDeviceGetAttribute(&cus, hipDeviceAttributeMultiprocessorCount, dev);
        hipFuncSetAttribute((const void*)hybrid_fwd, hipFuncAttributeMaxDynamicSharedMemorySize, (int)kDynLds);
        hipOccupancyMaxActiveBlocksPerMultiprocessor(&per_cu, (const void*)hybrid_fwd, 512, kDynLds);
        if (per_cu < 1) per_cu = 1;
        if (per_cu > 1) per_cu = 1;
        grid_blocks = cus * per_cu;
    }
    if (grid_blocks < 0) return;
    Params p{};
    for (int i = 0; i < 26; ++i) p.in[i] = (const float*)d_in[i];
    p.out = (float*)d_out; p.ws = (unsigned char*)d_ws;
    void* args[] = {&p};
    hipError_t e = hipLaunchCooperativeKernel((const void*)hybrid_fwd, dim3(grid_blocks), dim3(512), args, kDynLds, stream);
    if (e != hipSuccess) fprintf(stderr, "cooperative launch failed: %s (grid %d)\n", hipGetErrorString(e), grid_blocks);
}
```

```cpp
#include <hip/hip_runtime.h>
#include <hip/hip_cooperative_groups.h>
#include <cstdio>
namespace cg = cooperative_groups;

#define LAS __attribute__((address_space(3)))
typedef unsigned short bf16_t;
typedef short bf16x8 __attribute__((ext_vector_type(8)));
typedef float f32x4 __attribute__((ext_vector_type(4)));
typedef unsigned u32x4 __attribute__((ext_vector_type(4)));
typedef unsigned u32x2 __attribute__((ext_vector_type(2)));

constexpr int D = 1024, NB = 8, SEQ = 4096, DEPTH = 4, CTX = 256, DFF = 2816;
constexpr int MLAT = NB * SEQ, MCTX = NB * CTX, MTOT = MLAT + MCTX;
constexpr int NGU = 2 * DFF;
constexpr int NIN = 5376;
constexpr int INC = 5120;
constexpr int YLD = 1280;
constexpr int FTLD = SEQ + CTX;
constexpr int DMLD = 8192;
constexpr int NCHUNK = 544;

constexpr size_t WS_MODS = 0;
constexpr size_t WS_AGG  = WS_MODS + (size_t)4 * 9 * 9216 * 4;
constexpr size_t WS_HCTX = WS_AGG + (size_t)NCHUNK * 2 * 2 * 512 * 4;
constexpr size_t WS_ABUF = WS_HCTX + (size_t)MCTX * D * 4;
constexpr size_t WS_WGU  = WS_ABUF + (size_t)MTOT * D * 2;
constexpr size_t WS_WD   = WS_WGU + (size_t)2 * NGU * D * 2;
constexpr size_t WS_WIN  = WS_WD + (size_t)2 * D * DFF * 2;
constexpr size_t WS_WP   = WS_WIN + (size_t)NIN * D * 2;
constexpr size_t WS_WOUT = WS_WP + (size_t)D * YLD * 2;
constexpr size_t WS_DMAT = WS_WOUT + (size_t)D * D * 2;
constexpr size_t WS_MIX  = WS_DMAT + (size_t)FTLD * DMLD * 2;
constexpr size_t WS_FT   = WS_MIX;
constexpr size_t WS_XL   = WS_FT + (size_t)NB * 512 * FTLD * 2;
constexpr size_t WS_GG   = WS_XL + (size_t)MTOT * 512 * 2;
constexpr size_t WS_SCB  = WS_GG + (size_t)MTOT * 512 * 2;
constexpr size_t WS_CX   = WS_SCB + (size_t)MTOT * 256 * 2;
constexpr size_t WS_GATE = WS_CX + (size_t)MTOT * 256 * 2;
constexpr size_t WS_Y    = WS_GATE + (size_t)MTOT * 3072 * 2;
constexpr size_t WS_END  = WS_Y + (size_t)MTOT * YLD * 2;
constexpr size_t WS_FLAGS = WS_END;
constexpr size_t WS_ACT  = WS_MIX;
static_assert((size_t)MTOT * DFF * 2 <= WS_END - WS_MIX, "act alias");

struct Params { const float* in[26]; float* out; unsigned char* ws; };
constexpr int PT_OFF = 131072;
struct PT { LAS const unsigned* tab;
    __device__ __forceinline__ unsigned long long raw(int k) const { const unsigned lo = __builtin_amdgcn_readfirstlane(tab[2 * k]), hi = __builtin_amdgcn_readfirstlane(tab[2 * k + 1]); return ((unsigned long long)hi << 32) | lo; }
    __device__ __forceinline__ const float* in(int k) const { return (const float*)raw(k); }
    __device__ __forceinline__ float* out() const { return (float*)raw(26); }
    __device__ __forceinline__ unsigned char* ws() const { return (unsigned char*)raw(27); } };

typedef __bf16 bf16x2_t __attribute__((ext_vector_type(2)));
typedef float f32x2_t __attribute__((ext_vector_type(2)));
__device__ __forceinline__ unsigned cvt_pk_bf16(float lo, float hi) { const f32x2_t v = {lo, hi}; const bf16x2_t r = __builtin_convertvector(v, bf16x2_t); return __builtin_bit_cast(unsigned, r); }
__device__ __forceinline__ float bf2f(unsigned short b) { return __uint_as_float(((unsigned)b) << 16); }
__device__ __forceinline__ float bflo(unsigned w) { return __uint_as_float(w << 16); }
__device__ __forceinline__ float bfhi(unsigned w) { return __uint_as_float(w & 0xffff0000u); }
__device__ __forceinline__ float sigmoidf_(float x) { return __builtin_amdgcn_rcpf(1.0f + __expf(-x)); }
__device__ __forceinline__ float siluf_(float x) { return x * sigmoidf_(x); }
__device__ __forceinline__ float gelu_tanh_(float x) { const float z = 1.5957691216057308f * (x + 0.044715f * x * x * x); return x * sigmoidf_(z); }

__device__ __forceinline__ int otid() { int t = threadIdx.x; asm volatile("" : "+v"(t)); return t; }

namespace pg8 {
constexpr int BM = 256, BK = 64, HALF = 128, HTB = HALF * BK * 2, STAGE_BYTES = 8 * HTB, NXCD = 8, WGM = 8;
__device__ __forceinline__ int lds_byte(int r, int c) { const int st = (r >> 4) * 2 + (c >> 5), rr = r & 15, cc = c & 31, ob = rr * 64 + cc * 2; return st * 1024 + (ob ^ (((ob >> 9) & 1) << 5)); }
__device__ __forceinline__ void stage_rc(int b, int& R, int& C) { const int st = b / 1024, sb = b % 1024, swz = sb ^ (((sb >> 9) & 1) << 5); R = (st >> 1) * 16 + swz / 64; C = (st & 1) * 32 + (swz % 64) / 2; }
__device__ __forceinline__ int perm32(int rho) { const int n = rho >> 4, i = rho & 15; return 8 * (i >> 2) + 4 * n + (i & 3); }

struct Unit { const char* a; const char* b; int nt, pm, pn, aux; };

struct TileMap {
    int nM, nN, nwg, G, c;
    __device__ void init(int nM_, int nN_, int G_, int c_) { nM = nM_; nN = nN_; nwg = nM * nN; G = G_; c = c_; }
    __device__ bool tile(long L, int& pm, int& pn) const {
        if (L >= nwg) return false;
        int wgid = (int)L; { const int q = nwg / NXCD, r = nwg % NXCD, xcd = wgid % NXCD, off = wgid / NXCD; wgid = (xcd < r ? xcd * (q + 1) : r * (q + 1) + (xcd - r) * q) + off; }
        const int nig = WGM * nN, gid = wgid / nig, fm = gid * WGM, gsz = (nM - fm) < WGM ? (nM - fm) : WGM;
        pm = fm + ((wgid % nig) % gsz); pn = (wgid % nig) / gsz; return true;
    }
};

template <class Epi, class Sched>
__device__ __forceinline__ void gemm_phase(LAS unsigned char* lds, const int lda, const int ldb, const Sched& S, const Epi& E) {
    const int tid = otid(), wid = __builtin_amdgcn_readfirstlane(tid >> 6), lane = tid & 63, wr = wid >> 2, wc = wid & 3, fr = lane & 15, fq = lane >> 4;
    unsigned voffA[2], voffB[2];
#pragma unroll
    for (int i = 0; i < 2; ++i) { int R, C; stage_rc(tid * 16 + i * 8192, R, C); const int Rb = (R & ~31) + perm32(R & 31);
        voffA[i] = (unsigned)(R * lda + C) * 2u; voffB[i] = (unsigned)(Rb * ldb + C) * 2u; }
    const size_t kstep = (size_t)(BK * 2);
    const size_t hstepA = (size_t)HALF * lda * 2, hstepB = (size_t)HALF * ldb * 2;
    const unsigned ldsw = (unsigned)wid * 1024u;
    const int aoff = lds_byte(wr * 64 + fr, fq * 8), boff = lds_byte(wc * 32 + fr, fq * 8);
#define PG8_SA(b, h) (((b) * 2 + (h)) * HTB)
#define PG8_SB(b, h) ((4 + (b) * 2 + (h)) * HTB)
#define PG8_STAGE(bufoff, gbase, voff) do { _Pragma("unroll") for (int _i = 0; _i < 2; ++_i) \
        __builtin_amdgcn_global_load_lds((const unsigned*)((const char*)(gbase) + (voff)[_i]), (LAS unsigned*)(lds + (bufoff) + ldsw + _i * 8192), 16, 0, 0); } while (0)
#define PG8_LDA(dst, b, h) do { _Pragma("unroll") for (int m = 0; m < 4; ++m) _Pragma("unroll") for (int k = 0; k < 2; ++k) dst[m][k] = *(const LAS bf16x8*)(lds + PG8_SA(b, h) + aoff + m * 2048 + k * 1024); } while (0)
#define PG8_LDB(dst, b, h) do { _Pragma("unroll") for (int n = 0; n < 2; ++n) _Pragma("unroll") for (int k = 0; k < 2; ++k) dst[n][k] = *(const LAS bf16x8*)(lds + PG8_SB(b, h) + boff + n * 2048 + k * 1024); } while (0)
#define PG8_MMA(ai, bj, At, Bt) do { __builtin_amdgcn_s_setprio(1); _Pragma("unroll") for (int m = 0; m < 4; ++m) _Pragma("unroll") for (int n = 0; n < 2; ++n) _Pragma("unroll") for (int k = 0; k < 2; ++k) \
        acc[ai][bj][m][n] = __builtin_amdgcn_mfma_f32_16x16x32_bf16(Bt[n][k], At[m][k], acc[ai][bj][m][n], 0, 0, 0); __builtin_amdgcn_s_setprio(0); } while (0)
#define PG8_WAIT_V(n) asm volatile("s_waitcnt vmcnt(" #n ")" ::: "memory")
#define PG8_WAIT_L(n) asm volatile("s_waitcnt lgkmcnt(" #n ")" ::: "memory")
#define PG8_BAR __builtin_amdgcn_s_barrier()
#define PG8_SCHED __builtin_amdgcn_sched_barrier(0)
    Unit cur, nxt; int ui = 0;
    if (!S.next(0, cur)) return;
    f32x4 acc[2][2][4][2];
#pragma unroll
    for (int a = 0; a < 2; ++a)
#pragma unroll
        for (int b = 0; b < 2; ++b)
#pragma unroll
            for (int m = 0; m < 4; ++m)
#pragma unroll
                for (int n = 0; n < 2; ++n) acc[a][b][m][n] = (f32x4){0.f, 0.f, 0.f, 0.f};
    bf16x8 At[4][2], B0[2][2], B1[2][2];
    const char* cA = cur.a; const char* cB = cur.b;
    PG8_STAGE(PG8_SB(0, 0), cB, voffB); PG8_STAGE(PG8_SA(0, 0), cA, voffA); PG8_STAGE(PG8_SB(0, 1), cB + hstepB, voffB); PG8_STAGE(PG8_SA(0, 1), cA + hstepA, voffA);
    if (wr == 1) PG8_BAR;
    PG8_WAIT_V(4); PG8_BAR;
    PG8_STAGE(PG8_SB(1, 0), cB + kstep, voffB); PG8_STAGE(PG8_SA(1, 0), cA + kstep, voffA); PG8_STAGE(PG8_SB(1, 1), cB + hstepB + kstep, voffB);
    PG8_WAIT_V(6); PG8_BAR;
    for (;;) {
        const bool has_next = S.next(ui + 1, nxt);
        const char* nA = has_next ? nxt.a : cA; const char* nB = has_next ? nxt.b : cB;
        const int nt = cur.nt;
        for (int t = 0; t < nt; t += 2) {
            const bool last = (t == nt - 2);
            const char* a1 = cA + (size_t)(t + 1) * kstep;
            const char* a2 = last ? nA : cA + (size_t)(t + 2) * kstep; const char* b2 = last ? nB : cB + (size_t)(t + 2) * kstep;
            const char* a3 = a2 + kstep; const char* b3 = b2 + kstep;
            PG8_LDB(B0, 0, 0); PG8_SCHED; PG8_LDA(At, 0, 0); PG8_STAGE(PG8_SA(1, 1), a1 + hstepA, voffA);
            PG8_WAIT_L(8); PG8_BAR; PG8_WAIT_L(0); PG8_MMA(0, 0, At, B0); PG8_BAR; PG8_SCHED;
            PG8_LDB(B1, 0, 1); PG8_STAGE(PG8_SB(0, 0), b2, voffB);
            PG8_BAR; PG8_WAIT_L(0); PG8_MMA(0, 1, At, B1); PG8_BAR;
            PG8_LDA(At, 0, 1); PG8_STAGE(PG8_SA(0, 0), a2, voffA);
            PG8_BAR; PG8_WAIT_L(0); PG8_MMA(1, 0, At, B0); PG8_BAR; PG8_SCHED;
            PG8_STAGE(PG8_SB(0, 1), b2 + hstepB, voffB);
            PG8_WAIT_V(6); PG8_BAR; PG8_MMA(1, 1, At, B1); PG8_BAR;
            PG8_LDB(B0, 1, 0); PG8_SCHED; PG8_LDA(At, 1, 0); PG8_STAGE(PG8_SA(0, 1), a2 + hstepA, voffA);
            PG8_WAIT_L(8); PG8_BAR; PG8_WAIT_L(0); PG8_MMA(0, 0, At, B0); PG8_BAR; PG8_SCHED;
            PG8_LDB(B1, 1, 1); PG8_STAGE(PG8_SB(1, 0), b3, voffB);
            PG8_BAR; PG8_WAIT_L(0); PG8_MMA(0, 1, At, B1); PG8_BAR;
            PG8_LDA(At, 1, 1); PG8_STAGE(PG8_SA(1, 0), a3, voffA);
            PG8_BAR; PG8_WAIT_L(0); PG8_MMA(1, 0, At, B0); PG8_BAR; PG8_SCHED;
            PG8_STAGE(PG8_SB(1, 1), b3 + hstepB, voffB);
            PG8_WAIT_V(6); PG8_BAR; PG8_MMA(1, 1, At, B1); PG8_BAR;
        }
        E(acc, cur, wr, wc, fr, fq);
        if (!has_next) break;
#pragma unroll
        for (int a = 0; a < 2; ++a)
#pragma unroll
            for (int b = 0; b < 2; ++b)
#pragma unroll
                for (int m = 0; m < 4; ++m)
#pragma unroll
                    for (int n = 0; n < 2; ++n) acc[a][b][m][n] = (f32x4){0.f, 0.f, 0.f, 0.f};
        cur = nxt; cA = nA; cB = nB; ++ui;
    }
    PG8_WAIT_V(0);
    if (wr == 0) PG8_BAR;
    PG8_BAR;
#undef PG8_SA
#undef PG8_SB
#undef PG8_STAGE
#undef PG8_LDA
#undef PG8_LDB
#undef PG8_MMA
#undef PG8_WAIT_V
#undef PG8_WAIT_L
#undef PG8_BAR
#undef PG8_SCHED
}

struct SchedPlain : TileMap {
    const char* A; const char* B; size_t tstepA, tstepB; int nt;
    __device__ bool next(int i, Unit& u) const { int pm, pn; if (!tile((long)i * G + c, pm, pn)) return false;
        u.pm = pm; u.pn = pn; u.a = A + (size_t)pm * tstepA; u.b = B + (size_t)pn * tstepB; u.nt = nt; u.aux = 0; return true; }
};
struct SchedMerge : TileMap {
    const char* Y; const char* WP;
    __device__ bool next(int i, Unit& u) const { const int ti = i / 3, seg = i - ti * 3; int pm, pn; if (!tile((long)ti * G + c, pm, pn)) return false;
        const int koff = seg == 0 ? 0 : (seg == 1 ? 512 : 1024);
        u.pm = pm; u.pn = pn; u.a = Y + ((size_t)pm * 256 * YLD + koff) * 2; u.b = WP + ((size_t)pn * 256 * YLD + koff) * 2; u.nt = seg == 2 ? 4 : 8; u.aux = seg; return true; }
};
struct SchedDft {
    const char* DM; const char* FT; int G, c;
    __device__ bool next(int i, Unit& u) const { const int x = i * G + c; if (x >= 272) return false;
        if (x < 256) { const int b = x >> 5, rem = x & 31, pm = rem >> 1, h = rem & 1;
            u.a = DM + ((size_t)pm * 256 * DMLD + 4096 * h) * 2; u.b = FT + ((size_t)(b * 512 + 256 * h) * FTLD) * 2; u.nt = 64; u.pm = b * 16 + pm; u.pn = h; }
        else { const int cu = x - 256, b = cu >> 1, h = cu & 1;
            u.a = DM + ((size_t)4096 * DMLD + 256 * h) * 2; u.b = FT + ((size_t)(b * 512 + 256 * h) * FTLD + 4096) * 2; u.nt = 4; u.pm = 128 + b; u.pn = h; }
        u.aux = 0; return true; }
};

typedef f32x4 Acc[2][2][4][2];
template <int ACT> __device__ __forceinline__ void store_bf16_tile(const Acc& acc, bf16_t* base, const int ld) {
#pragma unroll
    for (int ai = 0; ai < 2; ++ai)
#pragma unroll
        for (int m = 0; m < 4; ++m) { bf16_t* rowp = base + (size_t)(ai * HALF + m * 16) * ld;
#pragma unroll
            for (int bj = 0; bj < 2; ++bj) { f32x4 v0 = acc[ai][bj][m][0], v1 = acc[ai][bj][m][1];
                if (ACT == 1) {
#pragma unroll
                    for (int j = 0; j < 4; ++j) { v0[j] = gelu_tanh_(v0[j]); v1[j] = gelu_tanh_(v1[j]); } }
                if (ACT == 2) {
#pragma unroll
                    for (int j = 0; j < 4; ++j) { v0[j] = sigmoidf_(v0[j]); v1[j] = sigmoidf_(v1[j]); } }
                u32x4 w; w.x = cvt_pk_bf16(v0[0], v0[1]); w.y = cvt_pk_bf16(v0[2], v0[3]); w.z = cvt_pk_bf16(v1[0], v1[1]); w.w = cvt_pk_bf16(v1[2], v1[3]);
                *(u32x4*)(rowp + bj * HALF) = w; } }
}

struct EpiUp {
    bf16_t* act;
    __device__ __forceinline__ void operator()(const Acc& acc, const Unit& u, int wr, int wc, int fr, int fq) const {
        bf16_t* base = act + (size_t)(u.pm * BM + wr * 64 + fr) * DFF + u.pn * 128 + wc * 32 + 8 * fq;
#pragma unroll
        for (int ai = 0; ai < 2; ++ai)
#pragma unroll
            for (int m = 0; m < 4; ++m) { const f32x4 g0 = acc[ai][0][m][0], g1 = acc[ai][0][m][1], u0 = acc[ai][1][m][0], u1 = acc[ai][1][m][1]; f32x4 v0, v1;
#pragma unroll
                for (int j = 0; j < 4; ++j) { v0[j] = siluf_(g0[j]) * u0[j]; v1[j] = siluf_(g1[j]) * u1[j]; }
                u32x4 w; w.x = cvt_pk_bf16(v0[0], v0[1]); w.y = cvt_pk_bf16(v0[2], v0[3]); w.z = cvt_pk_bf16(v1[0], v1[1]); w.w = cvt_pk_bf16(v1[2], v1[3]);
                *(u32x4*)(base + (size_t)(ai * HALF + m * 16) * DFF) = w; }
    }
};
struct EpiRes {
    const float* in_lat; const float* in_ctx; float* out_lat; float* out_ctx; const float* modv; float mult;
    __device__ __forceinline__ void operator()(const Acc& acc, const Unit& u, int wr, int wc, int fr, int fq) const {
        const bool lat = u.pm < 128; const int bidx = lat ? (u.pm >> 4) : 8;
        const int colo = u.pn * BM + wc * 32 + 8 * fq;
        const float* sv = modv + (size_t)bidx * 9216 + colo;
        f32x4 s[2][2];
#pragma unroll
        for (int bj = 0; bj < 2; ++bj)
#pragma unroll
            for (int n = 0; n < 2; ++n) s[bj][n] = *(const f32x4*)(sv + bj * HALF + 4 * n) * mult;
        const size_t rowl = (size_t)((lat ? u.pm : u.pm - 128) * BM + wr * 64 + fr);
        const float* ip = (lat ? in_lat : in_ctx) + rowl * D + colo; float* op = (lat ? out_lat : out_ctx) + rowl * D + colo;
#pragma unroll
        for (int ai = 0; ai < 2; ++ai)
#pragma unroll
            for (int m = 0; m < 4; ++m) { const size_t off = (size_t)(ai * HALF + m * 16) * D;
#pragma unroll
                for (int bj = 0; bj < 2; ++bj)
#pragma unroll
                    for (int n = 0; n < 2; ++n) { f32x4 r = *(const f32x4*)(ip + off + bj * HALF + 4 * n); r += s[bj][n] * acc[ai][bj][m][n]; *(f32x4*)(op + off + bj * HALF + 4 * n) = r; }
                asm volatile("" ::: "memory"); }
    }
};
struct EpiIn {
    bf16_t* FT; bf16_t* XL; bf16_t* GG; bf16_t* SCB; bf16_t* CX; bf16_t* GATE;
    __device__ __forceinline__ void operator()(const Acc& acc, const Unit& u, int wr, int wc, int fr, int fq) const {
        const int pn = u.pn; const size_t row0 = (size_t)(u.pm * BM + wr * 64 + fr); const int cw = wc * 32 + 8 * fq;
        if (pn >= 9) { store_bf16_tile<2>(acc, GATE + row0 * 3072 + (pn - 9) * 256 + cw, 3072); }
        else if (pn < 2) {
            const bool lat = u.pm < 128; const int b = lat ? (u.pm >> 4) : (u.pm - 128); const int tok0 = (lat ? (u.pm & 15) * 256 : 4096) + wr * 64 + fr;
            bf16_t* base = FT + ((size_t)(b * 512 + pn * 256 + cw) * FTLD) + tok0;
#pragma unroll
            for (int ai = 0; ai < 2; ++ai)
#pragma unroll
                for (int m = 0; m < 4; ++m)
#pragma unroll
                    for (int bj = 0; bj < 2; ++bj)
#pragma unroll
                        for (int n = 0; n < 2; ++n) { const f32x4 v = acc[ai][bj][m][n]; const unsigned w0 = cvt_pk_bf16(v[0], v[1]), w1 = cvt_pk_bf16(v[2], v[3]);
                            bf16_t* p = base + (size_t)(bj * HALF + 4 * n) * FTLD + ai * HALF + m * 16;
                            p[0] = (bf16_t)(w0 & 0xffffu); p[FTLD] = (bf16_t)(w0 >> 16); p[2 * FTLD] = (bf16_t)(w1 & 0xffffu); p[3 * FTLD] = (bf16_t)(w1 >> 16); asm volatile("" ::: "memory"); }
        }
        else if (pn < 4) { store_bf16_tile<0>(acc, XL + row0 * 512 + (pn - 2) * 256 + cw, 512); }
        else if (pn < 6) { store_bf16_tile<1>(acc, GG + row0 * 512 + (pn - 4) * 256 + cw, 512); }
        else if (pn == 6) { store_bf16_tile<0>(acc, SCB + row0 * 256 + cw, 256); }
        else {
            bf16_t* base = CX + row0 * 256 + (pn - 7) * 128 + cw;
#pragma unroll
            for (int ai = 0; ai < 2; ++ai)
#pragma unroll
                for (int m = 0; m < 4; ++m) { const f32x4 v0 = acc[ai][0][m][0] * acc[ai][1][m][0], v1 = acc[ai][0][m][1] * acc[ai][1][m][1];
                    u32x4 w; w.x = cvt_pk_bf16(v0[0], v0[1]); w.y = cvt_pk_bf16(v0[2], v0[3]); w.z = cvt_pk_bf16(v1[0], v1[1]); w.w = cvt_pk_bf16(v1[2], v1[3]);
                    *(u32x4*)(base + (size_t)(ai * HALF + m * 16) * 256) = w; }
        }
    }
};
struct EpiY {
    bf16_t* Y;
    __device__ __forceinline__ void operator()(const Acc& acc, const Unit& u, int wr, int wc, int fr, int fq) const {
#ifdef ZHALF
        if (u.pn == ZHALF) { Acc z;
#pragma unroll
            for (int a = 0; a < 2; ++a)
#pragma unroll
                for (int b = 0; b < 2; ++b)
#pragma unroll
                    for (int m = 0; m < 4; ++m)
#pragma unroll
                        for (int n = 0; n < 2; ++n) z[a][b][m][n] = (f32x4){0.f, 0.f, 0.f, 0.f};
            store_bf16_tile<0>(z, Y + (size_t)(u.pm * BM + wr * 64 + fr) * YLD + u.pn * 256 + wc * 32 + 8 * fq, YLD); return; }
#endif
        store_bf16_tile<0>(acc, Y + (size_t)(u.pm * BM + wr * 64 + fr) * YLD + u.pn * 256 + wc * 32 + 8 * fq, YLD);
    }
};
struct EpiMerge {
    const bf16_t* GATE; bf16_t* Mb;
    __device__ __forceinline__ void operator()(const Acc& acc, const Unit& u, int wr, int wc, int fr, int fq) const {
        const int seg = u.aux; const size_t row0 = (size_t)(u.pm * BM + wr * 64 + fr); const int col0 = u.pn * BM + wc * 32 + 8 * fq;
        const bf16_t* gp = GATE + row0 * 3072 + seg * 1024 + col0; bf16_t* mp = Mb + row0 * D + col0;
#ifdef MINV
        if (seg != 0) { asm volatile("s_waitcnt vmcnt(0)" ::: "memory"); __builtin_amdgcn_fence(__ATOMIC_ACQUIRE, "agent"); asm volatile("s_waitcnt vmcnt(0)" ::: "memory"); }
#endif
#pragma unroll
        for (int ai = 0; ai < 2; ++ai)
#pragma unroll
            for (int m = 0; m < 4; ++m)
#pragma unroll
                for (int bj = 0; bj < 2; ++bj) { const size_t ro = (size_t)(ai * HALF + m * 16);
                    const u32x4 g = *(const u32x4*)(gp + ro * 3072 + bj * HALF);
                    const f32x4 a0 = acc[ai][bj][m][0], a1 = acc[ai][bj][m][1];
                    float zb_ = 1.0f;
#ifdef ZB
                    if (seg == ZB) zb_ = 0.0f;
#endif
#ifdef BRI
                    if (seg == BRI) zb_ = BRS;
#endif
                    float o[8] = {bflo(g.x) * a0[0], bfhi(g.x) * a0[1], bflo(g.y) * a0[2], bfhi(g.y) * a0[3], bflo(g.z) * a1[0], bfhi(g.z) * a1[1], bflo(g.w) * a1[2], bfhi(g.w) * a1[3]};
#pragma unroll
                    for (int q_ = 0; q_ < 8; ++q_) o[q_] *= zb_;
                    if (seg != 0) { const u32x4 p = *(const u32x4*)(mp + ro * D + bj * HALF);
                        o[0] += bflo(p.x); o[1] += bfhi(p.x); o[2] += bflo(p.y); o[3] += bfhi(p.y); o[4] += bflo(p.z); o[5] += bfhi(p.z); o[6] += bflo(p.w); o[7] += bfhi(p.w); }
                    u32x4 w; w.x = cvt_pk_bf16(o[0], o[1]); w.y = cvt_pk_bf16(o[2], o[3]); w.z = cvt_pk_bf16(o[4], o[5]); w.w = cvt_pk_bf16(o[6], o[7]);
                    *(u32x4*)(mp + ro * D + bj * HALF) = w; asm volatile("" ::: "memory"); }
    }
};
}

__device__ __forceinline__ void norm_phase(const float* in_lat, const float* in_ctx, const float* gvec, const float* mshift, const float* mscale, bf16_t* outb, int nrows) {
    const int tx = otid(), wave = tx >> 6, lane = tx & 63;
    for (int row = blockIdx.x * 8 + wave; row < nrows; row += gridDim.x * 8) {
        const float* src = row < MLAT ? in_lat + (size_t)row * D : in_ctx + (size_t)(row - MLAT) * D;
        f32x4 v[4]; float ss = 0.f;
#pragma unroll
        for (int i = 0; i < 4; ++i) { v[i] = *(const f32x4*)(src + i * 256 + lane * 4); ss += v[i][0] * v[i][0] + v[i][1] * v[i][1] + v[i][2] * v[i][2] + v[i][3] * v[i][3]; }
#pragma unroll
        for (int o = 32; o >= 1; o >>= 1) ss += __shfl_xor(ss, o);
        const float rstd = rsqrtf(ss * (1.0f / D) + 1e-6f);
        const int bidx = row < MLAT ? (row >> 12) : 8;
#pragma unroll
        for (int i = 0; i < 4; ++i) { const int col = i * 256 + lane * 4;
            const f32x4 g = *(const f32x4*)(gvec + col), sc = *(const f32x4*)(mscale + (size_t)bidx * 9216 + col), sh = *(const f32x4*)(mshift + (size_t)bidx * 9216 + col);
            const f32x4 y = v[i] * rstd * g; const f32x4 o = y * (sc + 1.0f) + sh;
            u32x2 w; w.x = cvt_pk_bf16(o[0], o[1]); w.y = cvt_pk_bf16(o[2], o[3]);
            *(u32x2*)(outb + (size_t)row * D + col) = w; }
    }
}
__device__ __forceinline__ void final_norm_phase(float* io, const float* gvec) {
    const int tx = otid(), wave = tx >> 6, lane = tx & 63;
    for (int row = blockIdx.x * 8 + wave; row < MLAT; row += gridDim.x * 8) {
        float* src = io + (size_t)row * D;
        f32x4 v[4]; float ss = 0.f;
#pragma unroll
        for (int i = 0; i < 4; ++i) { v[i] = *(const f32x4*)(src + i * 256 + lane * 4); ss += v[i][0] * v[i][0] + v[i][1] * v[i][1] + v[i][2] * v[i][2] + v[i][3] * v[i][3]; }
#pragma unroll
        for (int o = 32; o >= 1; o >>= 1) ss += __shfl_xor(ss, o);
        const float rstd = rsqrtf(ss * (1.0f / D) + 1e-6f);
        float msk = 1.0f;
#if defined(MASKT)
        { const int t = row & 4095, bb = row >> 12; (void)bb;
          if (MASKT == 1 && ((t & 63) < 2 || (t & 63) >= 62)) msk = 0.f;
          if (MASKT == 2 && t < 256) msk = 0.f;
          if (MASKT == 3 && t >= 3840) msk = 0.f;
          if (MASKT == 4 && bb == 0) msk = 0.f;
          if (MASKT == 5 && (t & 63) >= 48) msk = 0.f;
          if (MASKT == 6 && (t & 63) < 16) msk = 0.f; }
#endif
#pragma unroll
        for (int i = 0; i < 4; ++i) { const int col = i * 256 + lane * 4; const f32x4 g = *(const f32x4*)(gvec + col); *(f32x4*)(src + col) = v[i] * (rstd * msk) * g; }
    }
}

__device__ __forceinline__ void load_tile_128x64(LAS float* T, const float* src, int ldsrc, int k0, int n0) {
    const int tid = otid(), j = tid & 63, i0 = tid >> 6;
    float v[16];
#pragma unroll
    for (int ii = 0; ii < 16; ++ii) v[ii] = src[(size_t)(k0 + i0 + 8 * ii) * ldsrc + n0 + j];
#pragma unroll
    for (int ii = 0; ii < 16; ++ii) T[(i0 + 8 * ii) * 65 + j] = v[ii];
}
__device__ __forceinline__ void cvt_tile(LAS float* T, const float* src, int ldsrc, int k0, int n0, bf16_t* dst, int ldd, int drow0, int dk0) {
    load_tile_128x64(T, src, ldsrc, k0, n0);
    __syncthreads();
    const int tid = otid(), ip = tid & 63, j0 = tid >> 6;
#pragma unroll
    for (int jj = 0; jj < 8; ++jj) { const int j = j0 + 8 * jj; const float lo = T[(2 * ip) * 65 + j], hi = T[(2 * ip + 1) * 65 + j];
        *(unsigned*)(dst + (size_t)(drow0 + j) * ldd + dk0 + 2 * ip) = cvt_pk_bf16(lo, hi); }
    __syncthreads();
}
__device__ __forceinline__ void convert_layer(const PT P, int l, LAS unsigned char* lds) {
    LAS float* T = (LAS float*)lds;
    unsigned char* ws = P.ws();
    bf16_t* WGU = (bf16_t*)(ws + WS_WGU); bf16_t* WD = (bf16_t*)(ws + WS_WD); bf16_t* WIN = (bf16_t*)(ws + WS_WIN); bf16_t* WP = (bf16_t*)(ws + WS_WP); bf16_t* WOUT = (bf16_t*)(ws + WS_WOUT);
    for (int task = blockIdx.x; task < 3040; task += gridDim.x) {
        int t = task; const float* win = P.in(12) + (size_t)l * D * INC;
        if (t < 1408) {
            const int which = t / 352, r = t % 352, kt = r / 44, ntile = r % 44, f = which & 1, isup = which >> 1;
            const float* src = (isup ? P.in(10) : P.in(9)) + (size_t)(l * 2 + f) * D * DFF;
            const int n0 = ntile * 64, drow0 = (n0 >> 7) * 256 + isup * 128 + (n0 & 127);
            cvt_tile(T, src, DFF, kt * 128, n0, WGU + (size_t)f * NGU * D, D, drow0, kt * 128);
            continue; }
        t -= 1408;
        if (t < 704) {
            const int f = t / 352, r = t % 352, kt = r / 16, ntile = r % 16;
            const float* src = P.in(11) + (size_t)(l * 2 + f) * DFF * D;
            cvt_tile(T, src, D, kt * 128, ntile * 64, WD + (size_t)f * D * DFF, DFF, ntile * 64, kt * 128);
            continue; }
        t -= 704;
        if (t < 608) {
            const int kt = t / 76, ntile = t % 76, n = 256 + ntile * 64; int drow0;
            if (n < 768) drow0 = 512 + (n - 256);
            else if (n < 1280) drow0 = 1024 + (n - 768);
            else if (n < 1536) drow0 = 1536 + (n - 1280);
            else if (n < 1792) { const int q = n - 1536; drow0 = 1792 + (q >> 7) * 256 + (q & 127); }
            else if (n < 2048) { const int q = n - 1792; drow0 = 1792 + (q >> 7) * 256 + 128 + (q & 127); }
            else drow0 = 2304 + (n - 2048);
            cvt_tile(T, win, INC, kt * 128, n, WIN, D, drow0, kt * 128);
            continue; }
        t -= 608;
        if (t < 64) {
            const int dup = t / 32, r = t % 32, kt = r / 16, ntile = r % 16;
            cvt_tile(T, P.in(21) + (size_t)l * 256 * D, D, kt * 128, ntile * 64, WP, YLD, ntile * 64, dup * 256 + kt * 128);
            continue; }
        t -= 64;
        if (t < 64) {
            const int kt = t / 16, ntile = t % 16;
            cvt_tile(T, P.in(22) + (size_t)l * 512 * D, D, kt * 128, ntile * 64, WP, YLD, ntile * 64, 512 + kt * 128);
            continue; }
        t -= 64;
        if (t < 32) {
            const int kt = t / 16, ntile = t % 16;
            cvt_tile(T, P.in(23) + (size_t)l * 256 * D, D, kt * 128, ntile * 64, WP, YLD, ntile * 64, 1024 + kt * 128);
            continue; }
        t -= 32;
        if (t < 128) {
            const int kt = t / 16, ntile = t % 16;
            cvt_tile(T, P.in(24) + (size_t)l * D * D, D, kt * 128, ntile * 64, WOUT, D, ntile * 64, kt * 128);
            continue; }
        t -= 128;
        {
            const int g = t / 8, kt = t % 8;
            load_tile_128x64(T, win, INC, kt * 128, 64 * g);
            LAS float* ct = T + 128 * 65; LAS float* st = ct + 64;
            const int tx = otid();
            if (tx < 64) { ct[tx] = cospif((float)tx * (1.0f / 32.0f)); st[tx] = sinpif((float)tx * (1.0f / 32.0f)); }
            __syncthreads();
            const int k = tx & 127, mg = tx >> 7;
            for (int mi = 0; mi < 16; ++mi) { const int m = mg * 16 + mi; float cs = 0.f, sn = 0.f;
#pragma unroll 8
                for (int j = 0; j < 64; ++j) { const float w = T[k * 65 + j]; const int q = (j * m) & 63; cs += w * ct[q]; sn += w * st[q]; }
                WIN[(size_t)(64 * g + m) * D + kt * 128 + k] = (bf16_t)(cvt_pk_bf16(cs, 0.f) & 0xffffu);
                WIN[(size_t)(256 + 64 * g + m) * D + kt * 128 + k] = (bf16_t)(cvt_pk_bf16(sn, 0.f) & 0xffffu); }
            __syncthreads();
        }
    }
}

__device__ __forceinline__ void prep_phase(const PT P, LAS unsigned char* lds) {
    LAS float* sl = (LAS float*)lds;
#ifdef SELFCHK
    if (blockIdx.x == 0 && threadIdx.x < 64) ((float*)(P.ws() + WS_FLAGS))[threadIdx.x] = threadIdx.x == 45 ? __int_as_float(0x7fffffff) : 0.f;
#endif
    float* mods = (float*)(P.ws() + WS_MODS); const float* cc = P.in(1); const float* cx_ = P.in(3);
    const int tx = otid();
    for (int idx = tx; idx < 9216; idx += 512) { const int b = idx >> 10, k = idx & 1023; const float v = b < 8 ? cc[b * 1024 + k] : cx_[k]; sl[idx] = v / (1.0f + expf(-v)); }
    __syncthreads();
    LAS float* red = (LAS float*)(lds + 40960);
    for (int task = blockIdx.x; task < 288; task += gridDim.x) {
        const int l = task / 72, cb = task % 72, cj = tx & 127, kq = tx >> 7; const int col = cb * 128 + cj;
        float acc[9];
#pragma unroll
        for (int b = 0; b < 9; ++b) acc[b] = 0.f;
        const float* wp = P.in(4) + ((size_t)l * 1024 + kq * 256) * 9216 + col;
#pragma unroll 8
        for (int k = 0; k < 256; ++k) { const float w = wp[(size_t)k * 9216];
#pragma unroll
            for (int b = 0; b < 9; ++b) acc[b] += sl[b * 1024 + kq * 256 + k] * w; }
#pragma unroll
        for (int b = 0; b < 9; ++b) red[(kq * 9 + b) * 128 + cj] = acc[b];
        __syncthreads();
        if (tx < 128) { const float bias = P.in(5)[l * 9216 + col];
#pragma unroll
            for (int b = 0; b < 9; ++b) mods[(size_t)(l * 9 + b) * 9216 + col] = ((red[(0 * 9 + b) * 128 + cj] + red[(1 * 9 + b) * 128 + cj]) + (red[(2 * 9 + b) * 128 + cj] + red[(3 * 9 + b) * 128 + cj])) + bias; }
        __syncthreads();
    }
    bf16_t* DM = (bf16_t*)(P.ws() + WS_DMAT);
    const int nthr = gridDim.x * 512;
    for (int it = blockIdx.x * 512 + tx; it < 4096 * 1024; it += nthr) {
        const int k = it >> 10, n0 = (it & 1023) * 8; float v[8];
#pragma unroll
        for (int e = 0; e < 8; ++e) { const int n = n0 + e, nn = n & 4095, idx = (k * nn) & 4095; const float x = (float)idx * (1.0f / 2048.0f);
            v[e] = (n < 4096 ? cospif(x) : -sinpif(x)) * (1.0f / 512.0f); }
        u32x4 w; w.x = cvt_pk_bf16(v[0], v[1]); w.y = cvt_pk_bf16(v[2], v[3]); w.z = cvt_pk_bf16(v[4], v[5]); w.w = cvt_pk_bf16(v[6], v[7]);
        *(u32x4*)(DM + (size_t)k * DMLD + n0) = w;
    }
    for (int it = blockIdx.x * 512 + tx; it < 256 * 64; it += nthr) {
        const int k = it >> 6, n0 = (it & 63) * 8; float v[8];
#pragma unroll
        for (int e = 0; e < 8; ++e) { const int n = n0 + e, nn = n & 255, idx = (k * nn) & 255; const float x = (float)idx * (1.0f / 128.0f);
            v[e] = (n < 256 ? cospif(x) : -sinpif(x)) * (1.0f / 128.0f); }
        u32x4 w; w.x = cvt_pk_bf16(v[0], v[1]); w.y = cvt_pk_bf16(v[2], v[3]); w.z = cvt_pk_bf16(v[4], v[5]); w.w = cvt_pk_bf16(v[6], v[7]);
        *(u32x4*)(DM + (size_t)(4096 + k) * DMLD + n0) = w;
    }
    __syncthreads();
}

struct ScanArgs { const float* cw; const float* cb; const float* wa; const float* ba; const float* wx; const float* bx; const float* lam; const float* scw;
                  const bf16_t* XL; const bf16_t* GG; const bf16_t* SCB; const bf16_t* CX; bf16_t* Y; float* agg; bf16_t* CA; };

template <int DIR>
__device__ __forceinline__ void scan_dir(const ScanArgs& A, LAS float* T, int blk, int row0, const int c) {
    const int head = c >> 6, cl = c & 63;
    const float sp8 = 8.0f * log1pf(expf(-A.lam[DIR * 512 + c]));
    const float ba_c = A.ba[(DIR * 8 + head) * 64 + cl], bx_c = A.bx[(DIR * 8 + head) * 64 + cl];
    const float* Wa = A.wa + (size_t)((DIR * 8 + head) * 64) * 64 + cl; const float* Wx = A.wx + (size_t)((DIR * 8 + head) * 64) * 64 + cl;
    bf16_t* CA = A.CA + (size_t)DIR * MTOT * 512;
    float h = 0.f, Ap = 1.f;
    for (int tgi = 0; tgi < 4; ++tgi) {
        const int tg = DIR == 0 ? tgi : 3 - tgi;
        float zr[16], zi[16];
#pragma unroll
        for (int tt = 0; tt < 16; ++tt) { zr[tt] = ba_c; zi[tt] = bx_c; }
        const LAS float* Tb = T + (tg * 16) * 512 + head * 64;
#pragma unroll 2
        for (int k = 0; k < 64; k += 4) {
            float wa[4], wx[4];
#pragma unroll
            for (int kk = 0; kk < 4; ++kk) { wa[kk] = Wa[(k + kk) * 64]; wx[kk] = Wx[(k + kk) * 64]; }
#pragma unroll
            for (int tt = 0; tt < 16; ++tt) { const f32x4 xv = *(const LAS f32x4*)(Tb + tt * 512 + k);
                zr[tt] += xv[0] * wa[0] + xv[1] * wa[1] + xv[2] * wa[2] + xv[3] * wa[3];
                zi[tt] += xv[0] * wx[0] + xv[1] * wx[1] + xv[2] * wx[2] + xv[3] * wx[3]; }
        }
#pragma unroll
        for (int tti = 0; tti < 16; ++tti) {
            const int tt = DIR == 0 ? tti : 15 - tti; const int t = tg * 16 + tt;
            const float r = sigmoidf_(zr[tt]), ig = sigmoidf_(zi[tt]);
            const float la = -sp8 * r, a = __expf(la), x2 = 2.0f * la;
            const float ser = -x2 * (1.0f + x2 * 0.5f * (1.0f + x2 * (1.0f / 3.0f) * (1.0f + x2 * 0.25f * (1.0f + x2 * 0.2f * (1.0f + x2 * (1.0f / 6.0f))))));
            const float om = x2 > -0.3f ? ser : 1.0f - __expf(x2);
            const float bt = sqrtf(om) * ig * T[t * 512 + c];
            h = a * h + bt; Ap *= a;
            bf16_t* yp = A.Y + (size_t)(row0 + t) * YLD + 512 + c;
            if (DIR == 0) *yp = (bf16_t)(cvt_pk_bf16(h, 0.f) & 0xffffu);
            else { const float hf = bf2f(*yp); *yp = (bf16_t)(cvt_pk_bf16(hf + h, 0.f) & 0xffffu); }
            CA[(size_t)(row0 + t) * 512 + c] = (bf16_t)(cvt_pk_bf16(Ap, 0.f) & 0xffffu);
        }
    }
    float* ag = A.agg + (size_t)blk * 2048 + DIR * 1024 + c; ag[0] = Ap; ag[512] = h;
}

__device__ void scan_phase(const ScanArgs& A, LAS unsigned char* lds) {
    LAS float* T = (LAS float*)lds;
    const int c = otid();
    for (int blk = blockIdx.x; blk < NCHUNK; blk += gridDim.x) {
        const bool lat = blk < 512; const int b = lat ? (blk >> 6) : ((blk - 512) >> 2), j = lat ? (blk & 63) : ((blk - 512) & 3);
        const int seq0 = lat ? b * SEQ : MLAT + b * CTX, seqlen = lat ? SEQ : CTX, row0 = seq0 + j * 64, tl0 = j * 64;
        {
            const float w0 = A.cw[c], w1 = A.cw[512 + c], w2 = A.cw[1024 + c], w3 = A.cw[1536 + c], bias = A.cb[c];
            const bf16_t* xp = A.XL + (size_t)row0 * 512 + c;
            float xm2 = tl0 >= 2 ? bf2f(xp[-2 * 512]) : 0.f, xm1 = tl0 >= 1 ? bf2f(xp[-512]) : 0.f, x0 = bf2f(xp[0]);
#pragma unroll 8
            for (int t = 0; t < 64; ++t) { const float xp1 = (tl0 + t + 1 < seqlen) ? bf2f(xp[(size_t)(t + 1) * 512]) : 0.f;
                T[t * 512 + c] = w0 * xm2 + w1 * xm1 + w2 * x0 + w3 * xp1 + bias; xm2 = xm1; xm1 = x0; x0 = xp1; }
        }
        {
            const int c2 = c & 255, th = c >> 8;
            const float w0 = A.scw[c2], w1 = A.scw[256 + c2], w2 = A.scw[512 + c2];
            for (int t = th * 32; t < th * 32 + 32; ++t) { const int tl = tl0 + t; const size_t row = (size_t)(row0 + t);
                const bool hasl = lat ? (t > 0) : (tl > 0), hasr = lat ? (t < 63) : (tl < CTX - 1);
                const float xl_ = hasl ? bf2f(A.CX[(row - 1) * 256 + c2]) : 0.f, xc_ = bf2f(A.CX[row * 256 + c2]), xr_ = hasr ? bf2f(A.CX[(row + 1) * 256 + c2]) : 0.f;
                const float v = bf2f(A.SCB[row * 256 + c2]) * (w0 * xl_ + w1 * xc_ + w2 * xr_);
                A.Y[row * YLD + 1024 + c2] = (bf16_t)(cvt_pk_bf16(v, 0.f) & 0xffffu); }
        }
        __syncthreads();
        scan_dir<0>(A, T, blk, row0, c);
        asm volatile("s_waitcnt vmcnt(0)" ::: "memory");
        scan_dir<1>(A, T, blk, row0, c);
        __syncthreads();
    }
}

__device__ void apply_phase(const ScanArgs& A) {
    const int c = otid();
    for (int blk = blockIdx.x; blk < NCHUNK; blk += gridDim.x) {
        const bool lat = blk < 512; const int b = lat ? (blk >> 6) : ((blk - 512) >> 2), j = lat ? (blk & 63) : ((blk - 512) & 3);
        const int row0 = (lat ? b * SEQ : MLAT + b * CTX) + j * 64;
        float cf = 0.f, cb = 0.f;
        { const float* ag = A.agg + c;
          if (lat) { for (int q = 0; q < 4; ++q) { const float* p = ag + (size_t)(512 + b * 4 + q) * 2048; cf = p[0] * cf + p[512]; }
                     for (int q = 0; q < j; ++q) { const float* p = ag + (size_t)(b * 64 + q) * 2048; cf = p[0] * cf + p[512]; } }
          else { for (int q = 0; q < j; ++q) { const float* p = ag + (size_t)(512 + b * 4 + q) * 2048; cf = p[0] * cf + p[512]; } }
          ag += 1024;
          if (lat) { for (int q = 3; q >= 0; --q) { const float* p = ag + (size_t)(512 + b * 4 + q) * 2048; cb = p[0] * cb + p[512]; }
                     for (int q = 63; q > j; --q) { const float* p = ag + (size_t)(b * 64 + q) * 2048; cb = p[0] * cb + p[512]; } }
          else { for (int q = 3; q > j; --q) { const float* p = ag + (size_t)(512 + b * 4 + q) * 2048; cb = p[0] * cb + p[512]; } } }
        const bf16_t* CAF = A.CA; const bf16_t* CAB = A.CA + (size_t)MTOT * 512;
#pragma unroll 8
        for (int t = 0; t < 64; ++t) { const size_t row = (size_t)(row0 + t); bf16_t* yp = A.Y + row * YLD + 512 + c;
            const float s_ = bf2f(*yp), caf = bf2f(CAF[row * 512 + c]), cab = bf2f(CAB[row * 512 + c]), gg = bf2f(A.GG[row * 512 + c]);
            *yp = (bf16_t)(cvt_pk_bf16((s_ + caf * cf + cab * cb) * gg, 0.f) & 0xffffu); }
    }
}

__global__ void __launch_bounds__(512, 2) hybrid_fwd(Params Pk) {
    extern __shared__ __attribute__((aligned(16))) unsigned char shm[];
    LAS unsigned char* lds = (LAS unsigned char*)shm;
    cg::grid_group grid = cg::this_grid();
    {
        LAS unsigned long long* t64 = (LAS unsigned long long*)(lds + PT_OFF);
        const int tx = otid();
        if (tx == 0) {
#pragma unroll
            for (int k = 0; k < 26; ++k) t64[k] = (unsigned long long)Pk.in[k];
            t64[26] = (unsigned long long)Pk.out; t64[27] = (unsigned long long)Pk.ws; }
        __syncthreads();
    }
    const PT P{(LAS const unsigned*)(lds + PT_OFF)};
    const int G = gridDim.x, cid = blockIdx.x;
#ifndef PHM
#define PHM 0xffff
#endif
#define PH(k) if ((PHM >> (k)) & 1)
#define GRID_SYNC() do { asm volatile("s_waitcnt vmcnt(0) lgkmcnt(0)" ::: "memory"); __builtin_amdgcn_fence(__ATOMIC_RELEASE, "agent"); asm volatile("s_waitcnt vmcnt(0)" ::: "memory"); grid.sync(); __builtin_amdgcn_fence(__ATOMIC_ACQUIRE, "agent"); asm volatile("s_waitcnt vmcnt(0)" ::: "memory"); } while (0)
#define MODS(ws_, l_) ((const float*)((ws_) + WS_MODS) + (size_t)(l_) * 9 * 9216)

    PH(0) prep_phase(P, lds);
    GRID_SYNC();

    for (int l = 0; l < DEPTH; ++l) {
        PH(1) { unsigned char* ws = P.ws(); const float* ml = MODS(ws, l);
            norm_phase(l == 0 ? P.in(0) : P.out(), l == 0 ? P.in(2) : (const float*)(ws + WS_HCTX), P.in(6) + l * D, ml + 0 * 1024, ml + 1 * 1024, (bf16_t*)(ws + WS_ABUF), MTOT); }
        PH(2) convert_layer(P, l, lds);
        GRID_SYNC();
        for (int f = 0; f < 2; ++f) {
            if (f == 1) { PH(1) { unsigned char* ws = P.ws(); const float* ml = MODS(ws, l);
                norm_phase(P.out(), (const float*)(ws + WS_HCTX), P.in(8) + l * D, ml + 6 * 1024, ml + 7 * 1024, (bf16_t*)(ws + WS_ABUF), MTOT); } GRID_SYNC(); }
            PH(3) { unsigned char* ws = P.ws(); pg8::SchedPlain S; S.init(136, 22, G, cid); S.A = (const char*)(ws + WS_ABUF); S.B = (const char*)(ws + WS_WGU) + (size_t)f * NGU * D * 2; S.tstepA = (size_t)256 * D * 2; S.tstepB = (size_t)256 * D * 2; S.nt = D / 64;
              pg8::EpiUp E{(bf16_t*)(ws + WS_ACT)}; pg8::gemm_phase(lds, D, D, S, E); }
            GRID_SYNC();
#ifdef SELFCHK
            if (l == 0 && f == 0 && blockIdx.x == 0) {
                unsigned char* ws = P.ws(); const bf16_t* Ab = (const bf16_t*)(ws + WS_ABUF); const bf16_t* Ac = (const bf16_t*)(ws + WS_ACT); float* fl = (float*)(ws + WS_FLAGS);
                const float* wg = P.in(9); const float* wu = P.in(10); const int tx = otid();
                const int row = (tx * 7919 + 13) % MTOT, j = (tx * 104729 + 7) % DFF; float dg = 0.f, du = 0.f;
                for (int k = 0; k < D; ++k) { const float a = bf2f(Ab[(size_t)row * D + k]); dg += a * wg[(size_t)k * DFF + j]; du += a * wu[(size_t)k * DFF + j]; }
                const float ex = siluf_(dg) * du, got = bf2f(Ac[(size_t)row * DFF + j]);
                if (fabsf(got - ex) > 0.03f * fabsf(ex) + 0.05f) fl[4] = 1.f;
            }
#endif
            PH(4) { unsigned char* ws = P.ws(); pg8::SchedPlain S; S.init(136, 4, G, cid); S.A = (const char*)(ws + WS_ACT); S.B = (const char*)(ws + WS_WD) + (size_t)f * D * DFF * 2; S.tstepA = (size_t)256 * DFF * 2; S.tstepB = (size_t)256 * DFF * 2; S.nt = DFF / 64;
              const bool first = (l == 0 && f == 0); float* hctx = (float*)(ws + WS_HCTX); float* outp = P.out();
              pg8::EpiRes E{first ? P.in(0) : outp, first ? P.in(2) : hctx, outp, hctx, MODS(ws, l) + (f == 0 ? 2 : 8) * 1024, 0.5f}; pg8::gemm_phase(lds, DFF, DFF, S, E); }
            GRID_SYNC();
            if (f == 1) break;
            PH(1) { unsigned char* ws = P.ws(); const float* ml = MODS(ws, l);
                norm_phase(P.out(), (const float*)(ws + WS_HCTX), P.in(7) + l * D, ml + 3 * 1024, ml + 4 * 1024, (bf16_t*)(ws + WS_ABUF), MTOT); }
            GRID_SYNC();
#if defined(DBG_STAGE) && DBG_STAGE == 8
            if (l == DBG_L) { const bf16_t* Ad = (const bf16_t*)(P.ws() + WS_ABUF); float* o = P.out();
                for (size_t i = (size_t)blockIdx.x * 512 + otid(); i < (size_t)MLAT * 1024; i += (size_t)gridDim.x * 512) o[i] = bf2f(Ad[i]);
                return; }
#endif
            PH(5) { unsigned char* ws = P.ws(); pg8::SchedPlain S; S.init(136, 21, G, cid); S.A = (const char*)(ws + WS_ABUF); S.B = (const char*)(ws + WS_WIN); S.tstepA = (size_t)256 * D * 2; S.tstepB = (size_t)256 * D * 2; S.nt = D / 64;
              pg8::EpiIn E{(bf16_t*)(ws + WS_FT), (bf16_t*)(ws + WS_XL), (bf16_t*)(ws + WS_GG), (bf16_t*)(ws + WS_SCB), (bf16_t*)(ws + WS_CX), (bf16_t*)(ws + WS_GATE)}; pg8::gemm_phase(lds, D, D, S, E); }
            GRID_SYNC();
#if defined(DBG_STAGE) && DBG_STAGE == 7
            if (l == DBG_L) { const bf16_t* Xd = (const bf16_t*)(P.ws() + WS_XL); const bf16_t* Gd = (const bf16_t*)(P.ws() + WS_GG); float* o = P.out();
                for (size_t i = (size_t)blockIdx.x * 512 + otid(); i < (size_t)MLAT * 1024; i += (size_t)gridDim.x * 512) { const size_t r = i >> 10, c_ = i & 1023; o[i] = c_ < 512 ? bf2f(Xd[r * 512 + c_]) : bf2f(Gd[r * 512 + c_ - 512]); }
                return; }
#endif
#ifndef FAILTX
#define FAILTX 0
#endif
#ifndef MINTX
#define MINTX -1
#endif
#ifdef SELFCHK
            if (l == 0 && blockIdx.x == 0) {
                unsigned char* ws = P.ws(); const bf16_t* Ab = (const bf16_t*)(ws + WS_ABUF); float* fl = (float*)(ws + WS_FLAGS); const float* win = P.in(12); const int tx = otid();
                const bf16_t* Wn = (const bf16_t*)(ws + WS_WIN);
                const int row = (tx * 7919 + 13) % MTOT;
                {
                    const int c_ = (tx * 104729 + 7) % 512; float d = 0.f; bool cvbad = false;
                    for (int k = 0; k < D; ++k) { const float w = win[(size_t)k * INC + 256 + c_]; d += bf2f(Ab[(size_t)row * D + k]) * w;
                        const float wb = bf2f(Wn[(size_t)(512 + c_) * D + k]); if (fabsf(wb - w) > 0.01f * fabsf(w) + 1e-6f) cvbad = true; }
                    if (cvbad) fl[1] = 1.f;
                    const float got = bf2f(((const bf16_t*)(ws + WS_XL))[(size_t)row * 512 + c_]);
                    if (fabsf(got - d) > 0.03f * fabsf(d) + 0.05f) fl[2] = 1.f;
                }
                {
                    for (int sidx = 0; sidx < 64; ++sidx) { const unsigned hsh = ((unsigned)tx * 64u + (unsigned)sidx) * 2654435761u;
                        const int drow = 512 + (int)((hsh >> 8) % 4864u), k = (int)(hsh & 1023u); int n;
                        if (drow < 1024) n = 256 + (drow - 512); else if (drow < 1536) n = 768 + (drow - 1024); else if (drow < 1792) n = 1280 + (drow - 1536);
                        else if (drow < 2304) { const int q = drow - 1792, t_ = q >> 8, r_ = q & 255; n = r_ < 128 ? 1536 + t_ * 128 + r_ : 1792 + t_ * 128 + (r_ - 128); }
                        else n = 2048 + (drow - 2304);
                        const float w = win[(size_t)k * INC + n], wb = bf2f(Wn[(size_t)drow * D + k]);
                        if (fabsf(wb - w) > 0.01f * fabsf(w) + 1e-6f) atomicAdd(&fl[40], 1.0f); }
                }
                {
                    const int c_ = (int)(((unsigned)tx * 15485863u + 11u) % 3072u); float d = 0.f;
                    for (int k = 0; k < D; ++k) d += bf2f(Ab[(size_t)row * D + k]) * win[(size_t)k * INC + 2048 + c_];
                    const float got = bf2f(((const bf16_t*)(ws + WS_GATE))[(size_t)row * 3072 + c_]);
                    if (fabsf(got - sigmoidf_(d)) > 0.02f) { fl[3] = 1.f; atomicAdd(&fl[20], 1.0f); atomicAdd(&fl[21 + c_ / 256], 1.0f); if (tx == FAILTX) { fl[41] = (float)c_; fl[42] = (float)row; fl[43] = got; fl[44] = sigmoidf_(d); } if (tx > MINTX) atomicMin((int*)&fl[45], tx + 1000000); if (row >= MLAT) atomicAdd(&fl[46], 1.0f); }
                }
                {
                    const int c_ = (tx * 104729 + 7) % 512; float d = 0.f;
                    for (int k = 0; k < D; ++k) d += bf2f(Ab[(size_t)row * D + k]) * win[(size_t)k * INC + 768 + c_];
                    const float got = bf2f(((const bf16_t*)(ws + WS_GG))[(size_t)row * 512 + c_]); const float ex = gelu_tanh_(d);
                    if (fabsf(got - ex) > 0.03f * fabsf(ex) + 0.05f) fl[5] = 1.f;
                    const int c2 = c_ & 255; float db = 0.f, dc = 0.f, dx = 0.f;
                    for (int k = 0; k < D; ++k) { const float a = bf2f(Ab[(size_t)row * D + k]); db += a * win[(size_t)k * INC + 1280 + c2]; dc += a * win[(size_t)k * INC + 1536 + c2]; dx += a * win[(size_t)k * INC + 1792 + c2]; }
                    const float gb = bf2f(((const bf16_t*)(ws + WS_SCB))[(size_t)row * 256 + c2]), gc = bf2f(((const bf16_t*)(ws + WS_CX))[(size_t)row * 256 + c2]);
                    if (fabsf(gb - db) > 0.03f * fabsf(db) + 0.05f) fl[6] = 1.f;
                    if (fabsf(gc - dc * dx) > 0.04f * fabsf(dc * dx) + 0.08f) fl[7] = 1.f;
                }
            }
#endif
#define SCANARGS(ws_) ScanArgs{P.in(13) + l * 4 * 512, P.in(14) + l * 512, P.in(15) + (size_t)l * 2 * 8 * 64 * 64, P.in(16) + l * 2 * 512, P.in(17) + (size_t)l * 2 * 8 * 64 * 64, P.in(18) + l * 2 * 512, \
                        P.in(19) + l * 2 * 512, P.in(20) + l * 3 * 256, (const bf16_t*)((ws_) + WS_XL), (const bf16_t*)((ws_) + WS_GG), (const bf16_t*)((ws_) + WS_SCB), (const bf16_t*)((ws_) + WS_CX), (bf16_t*)((ws_) + WS_Y), (float*)((ws_) + WS_AGG), (bf16_t*)((ws_) + WS_ABUF)}
            PH(6) { unsigned char* ws = P.ws(); const ScanArgs SA = SCANARGS(ws); scan_phase(SA, lds); }
            GRID_SYNC();
#ifdef SELFCHK
            if (l == 0 && blockIdx.x == 0) {
                unsigned char* ws = P.ws(); const bf16_t* Ab = (const bf16_t*)(ws + WS_ABUF); float* fl = (float*)(ws + WS_FLAGS); const float* win = P.in(12); const int tx = otid();
                const int row = (tx * 7919 + 13) % MTOT; const int c_ = (int)(((unsigned)tx * 15485863u + 11u) % 3072u); float d = 0.f;
                for (int k = 0; k < D; ++k) d += bf2f(Ab[(size_t)row * D + k]) * win[(size_t)k * INC + 2048 + c_];
                const float got = bf2f(((const bf16_t*)(ws + WS_GATE))[(size_t)row * 3072 + c_]);
                if (fabsf(got - sigmoidf_(d)) > 0.02f) atomicAdd(&fl[47], 1.0f);
            }
#endif
            PH(7) { unsigned char* ws = P.ws(); const ScanArgs SA = SCANARGS(ws); apply_phase(SA); }
            PH(8) { unsigned char* ws = P.ws(); pg8::SchedDft S{(const char*)(ws + WS_DMAT), (const char*)(ws + WS_FT), G, cid}; pg8::EpiY E{(bf16_t*)(ws + WS_Y)}; pg8::gemm_phase(lds, DMLD, FTLD, S, E); }
            GRID_SYNC();
#if defined(DBG_STAGE) && DBG_STAGE == 1
            if (l == DBG_L) { const bf16_t* Yd = (const bf16_t*)(P.ws() + WS_Y); float* o = P.out();
                for (size_t i = (size_t)blockIdx.x * 512 + otid(); i < (size_t)MLAT * 1024; i += (size_t)gridDim.x * 512) { const size_t r = i >> 10, c_ = i & 1023; o[i] = bf2f(Yd[r * YLD + c_]); }
                return; }
#endif
#if defined(DBG_STAGE) && DBG_STAGE == 2
            if (l == DBG_L) { const bf16_t* Yd = (const bf16_t*)(P.ws() + WS_Y); const bf16_t* Gd = (const bf16_t*)(P.ws() + WS_GATE); float* o = P.out();
                for (size_t i = (size_t)blockIdx.x * 512 + otid(); i < (size_t)MLAT * 1024; i += (size_t)gridDim.x * 512) { const size_t r = i >> 10, c_ = i & 1023; o[i] = c_ < 256 ? bf2f(Yd[r * YLD + 1024 + c_]) : bf2f(Gd[r * 3072 + c_]); }
                return; }
#endif
            PH(9) { unsigned char* ws = P.ws(); pg8::SchedMerge S; S.init(136, 4, G, cid); S.Y = (const char*)(ws + WS_Y); S.WP = (const char*)(ws + WS_WP); pg8::EpiMerge E{(const bf16_t*)(ws + WS_GATE), (bf16_t*)(ws + WS_ABUF)}; pg8::gemm_phase(lds, YLD, YLD, S, E); }
            GRID_SYNC();
#if defined(DBG_STAGE) && DBG_STAGE == 3
            if (l == DBG_L) { const bf16_t* Md = (const bf16_t*)(P.ws() + WS_ABUF); float* o = P.out();
                for (size_t i = (size_t)blockIdx.x * 512 + otid(); i < (size_t)MLAT * 1024; i += (size_t)gridDim.x * 512) o[i] = bf2f(Md[i]);
                return; }
#endif
            PH(10) { unsigned char* ws = P.ws(); pg8::SchedPlain S; S.init(136, 4, G, cid); S.A = (const char*)(ws + WS_ABUF); S.B = (const char*)(ws + WS_WOUT); S.tstepA = (size_t)256 * D * 2; S.tstepB = (size_t)256 * D * 2; S.nt = D / 64;
              float* hctx = (float*)(ws + WS_HCTX); float* outp = P.out();
              pg8::EpiRes E{outp, hctx, outp, hctx, MODS(ws, l) + 5 * 1024, 1.0f}; pg8::gemm_phase(lds, D, D, S, E); }
            GRID_SYNC();
#if defined(DBG_STAGE) && DBG_STAGE == 4
            if (l == 0) return;
#endif
        }
#if defined(DBG_STAGE) && DBG_STAGE == 5
        if (l == 0) return;
#endif
#if defined(DBG_STAGE) && DBG_STAGE == 6
        if (l == 1) return;
#endif
    }
    PH(11) final_norm_phase(P.out(), P.in(25));
#ifdef SELFCHK
    GRID_SYNC();
    { const float* fl = (const float*)(P.ws() + WS_FLAGS); float sc = 1.f;
#if SELFCHK == 1
      for (int q = 1; q < 16; ++q) if (fl[q] != 0.f) sc += (float)(1 << q);
#elif SELFCHK == 2
      sc += fl[20];
#elif SELFCHK == 20
      sc += fl[40];
#elif SELFCHK == 30
      sc += (float)(__float_as_int(fl[45]) - 1000000 - MINTX) * 10.f;
#elif SELFCHK == 36
      sc += fl[47];
#elif SELFCHK == 35
      sc += fl[46];
#elif SELFCHK == 31
      sc += fl[41];
#elif SELFCHK == 32
      sc += fl[42];
#elif SELFCHK == 33
      sc += fl[43] * 1000.f;
#elif SELFCHK == 34
      sc += fl[44] * 1000.f;
#else
      sc += fl[21 + SELFCHK - 3];
#endif
      if (sc != 1.f) { float* o = P.out(); for (size_t i = (size_t)blockIdx.x * 512 + otid(); i < (size_t)MLAT * 1024; i += (size_t)gridDim.x * 512) o[i] *= sc; } }
#endif
}

extern "C" void kernel_launch(void* const* d_in, const int* in_sizes, int n_in, void* d_out, int out_size, void* d_ws, size_t ws_size, hipStream_t stream) {
    static int grid_blocks = 0;
    constexpr size_t kDynLds = pg8::STAGE_BYTES + 256;
    if (!grid_blocks) {
        if (ws_size < WS_END) { fprintf(stderr, "kernel_launch: workspace too small: %zu < %zu\n", ws_size, (size_t)WS_END); grid_blocks = -1; return; }
        int dev = 0, cus = 0, per_cu = 0;
        hipGetDevice(&dev);
        hipDeviceGetAttribute(&cus, hipDeviceAttributeMultiprocessorCount, dev);
        hipFuncSetAttribute((const void*)hybrid_fwd, hipFuncAttributeMaxDynamicSharedMemorySize, (int)kDynLds);
        hipOccupancyMaxActiveBlocksPerMultiprocessor(&per_cu, (const void*)hybrid_fwd, 512, kDynLds);
        if (per_cu < 1) per_cu = 1;
        if (per_cu > 1) per_cu = 1;
        grid_blocks = cus * per_cu;
    }
    if (grid_blocks < 0) return;
    Params p{};
    for (int i = 0; i < 26; ++i) p.in[i] = (const float*)d_in[i];
    p.out = (float*)d_out; p.ws = (unsigned char*)d_ws;
    void* args[] = {&p};
    hipError_t e = hipLaunchCooperativeKernel((const void*)hybrid_fwd, dim3(grid_blocks), dim3(512), args, kDynLds, stream);
    if (e != hipSuccess) fprintf(stderr, "cooperative launch failed: %s (grid %d)\n", hipGetErrorString(e), grid_blocks);
}
```
